# Optimizing an MI355X kernel written in HIP

```python
import math
import jax, jax.numpy as jnp
from jax import lax
import numpy as np

D_MODEL = 1024
BATCH = 16
SEQ = 4096
DEPTH = 2

GRID_W = 64
CTX_LEN = 256
EPS = 1e-6
ROPE_BASE = 10000.0
NEG_INF = -1e30

MLA_HEADS = 4
MLA_NOPE = 64
MLA_ROPE = 32
MLA_V = 64
MLA_Q_RANK = 256
MLA_KV_RANK = 128
MLA_SCALE = (MLA_NOPE + MLA_ROPE) ** -0.5
SWA_HEADS = 4
SWA_KV_HEADS = 2
SWA_HEAD_DIM = 64
WINDOW = 128
BLOCK = 128
LRU_WIDTH = 512
LRU_BLOCKS = 8
LRU_BW = LRU_WIDTH // LRU_BLOCKS
CONV_W = 4
CONV_LEFT = CONV_W // 2
CONV_RIGHT = CONV_W - 1 - CONV_W // 2
LRU_C = 8.0
N_GROUPS = 4
EXPERTS_PER_GROUP = 8
N_EXPERTS = N_GROUPS * EXPERTS_PER_GROUP
TOP_K = 2
D_EXPERT = 256

MLA_OUT = MLA_HEADS * MLA_V
SWA_OUT = SWA_HEADS * SWA_HEAD_DIM
MIX_WIDTH = MLA_OUT + SWA_OUT + LRU_WIDTH
IN_SIZES = (MLA_Q_RANK, MLA_KV_RANK, MLA_ROPE, SWA_HEADS * SWA_HEAD_DIM, SWA_KV_HEADS * SWA_HEAD_DIM, SWA_KV_HEADS * SWA_HEAD_DIM, LRU_WIDTH, LRU_WIDTH)
IN_COLS = sum(IN_SIZES)

kernel_name = 'hybrid_mla_swa_rglru_hmoe_dit'


def rmsnorm(x, g):
    xf = x.astype(jnp.float32)
    y = xf * lax.rsqrt(jnp.mean(xf * xf, axis=-1, keepdims=True) + EPS)
    return (y * g.astype(jnp.float32)).astype(x.dtype)


def rope_1d(x, pos):
    half = x.shape[-1] // 2
    freqs = ROPE_BASE ** (-jnp.arange(half, dtype=jnp.float32) / half)
    ang = pos.astype(jnp.float32)[:, None] * freqs[None, :]
    cos = jnp.cos(ang)[:, None, :]
    sin = jnp.sin(ang)[:, None, :]
    xf = x.astype(jnp.float32)
    x1, x2 = xf[..., :half], xf[..., half:]
    return jnp.concatenate([x1 * cos - x2 * sin, x2 * cos + x1 * sin], axis=-1).astype(x.dtype)


def rope_2d(x, rows, cols):
    d = x.shape[-1] // 2
    return jnp.concatenate([rope_1d(x[..., :d], rows), rope_1d(x[..., d:], cols)], axis=-1)


def split_cols(z):
    out = []
    o = 0
    for n in IN_SIZES:
        out.append(z[..., o:o + n])
        o += n
    return out


def mla_q(z_cq, g_cq, w_uq, rows, cols):
    B, S = z_cq.shape[:2]
    q = (rmsnorm(z_cq, g_cq) @ w_uq).reshape(B, S, MLA_HEADS, MLA_NOPE + MLA_ROPE)
    q_nope, q_rope = q[..., :MLA_NOPE], q[..., MLA_NOPE:]
    if rows is not None:
        q_rope = rope_2d(q_rope, rows, cols)
    return jnp.concatenate([q_nope, q_rope], axis=-1)


def mla_kv(z_ckv, z_kr, g_ckv, w_ukv, rows, cols):
    B, S = z_ckv.shape[:2]
    kv = (rmsnorm(z_ckv, g_ckv) @ w_ukv).reshape(B, S, MLA_HEADS, MLA_NOPE + MLA_V)
    k_nope, v = kv[..., :MLA_NOPE], kv[..., MLA_NOPE:]
    k_rope = z_kr[:, :, None, :]
    if rows is not None:
        k_rope = rope_2d(k_rope, rows, cols)
    k = jnp.concatenate([k_nope, jnp.broadcast_to(k_rope, (B, S, MLA_HEADS, MLA_ROPE))], axis=-1)
    return k, v


def dense_attention(q, k, v, scale):
    B, L, H, _ = q.shape
    s = jnp.einsum('blhd,bjhd->bhlj', q, k).astype(jnp.float32) * scale
    p = jax.nn.softmax(s, axis=-1).astype(v.dtype)
    return jnp.einsum('bhlj,bjhd->blhd', p, v).reshape(B, L, H * v.shape[-1])


def blockwise_attention(q, k, v, scale):
    B, S, H, dq = q.shape
    nb = S // BLOCK
    qb = jnp.moveaxis(q.reshape(B, nb, BLOCK, H, dq), 1, 0)

    def one(qblk):
        s = jnp.einsum('bqhd,bjhd->bhqj', qblk, k).astype(jnp.float32) * scale
        p = jax.nn.softmax(s, axis=-1).astype(v.dtype)
        return jnp.einsum('bhqj,bjhd->bqhd', p, v)

    o = lax.map(one, qb)
    return jnp.moveaxis(o, 0, 1).reshape(B, S, H * v.shape[-1])


def sink_attention(q, k, v, sink):
    B, L, Hq, hd = q.shape
    KV = k.shape[2]
    G = Hq // KV
    qg = q.reshape(B, L, KV, G, hd)
    s = jnp.einsum('blkgd,bjkd->bkglj', qg, k).astype(jnp.float32) * (hd ** -0.5)
    s_sink = jnp.broadcast_to(sink.astype(jnp.float32).reshape(KV, G)[None, :, :, None, None], s.shape[:-1] + (1,))
    p = jax.nn.softmax(jnp.concatenate([s, s_sink], axis=-1), axis=-1)[..., :-1].astype(v.dtype)
    return jnp.einsum('bkglj,bjkd->blkgd', p, v).reshape(B, L, Hq * hd)


def banded_sink_attention(q, k, v, k_ctx, v_ctx, sink):
    B, S, Hq, hd = q.shape
    KV = k.shape[2]
    G = Hq // KV
    L = k_ctx.shape[1]
    nb = S // BLOCK
    span = BLOCK + 2 * WINDOW
    scale = hd ** -0.5
    pad = ((0, 0), (WINDOW, WINDOW), (0, 0), (0, 0))
    kpad = jnp.pad(k, pad)
    vpad = jnp.pad(v, pad)
    qb = jnp.moveaxis(q.reshape(B, nb, BLOCK, KV, G, hd), 1, 0)
    sink_kg = sink.astype(jnp.float32).reshape(KV, G)

    def one(args):
        n, qblk = args
        start = n * BLOCK
        kw = lax.dynamic_slice_in_dim(kpad, start, span, axis=1)
        vw = lax.dynamic_slice_in_dim(vpad, start, span, axis=1)
        qpos = start + jnp.arange(BLOCK)
        kpos = start - WINDOW + jnp.arange(span)
        valid = (jnp.abs(qpos[:, None] - kpos[None, :]) <= WINDOW) & (kpos >= 0)[None, :] & (kpos < S)[None, :]
        s_loc = jnp.einsum('bqkgd,bjkd->bkgqj', qblk, kw).astype(jnp.float32) * scale
        s_loc = jnp.where(valid, s_loc, NEG_INF)
        s_ctx = jnp.einsum('bqkgd,bjkd->bkgqj', qblk, k_ctx).astype(jnp.float32) * scale
        s_sink = jnp.broadcast_to(sink_kg[None, :, :, None, None], s_loc.shape[:-1] + (1,))
        p = jax.nn.softmax(jnp.concatenate([s_loc, s_ctx, s_sink], axis=-1), axis=-1).astype(v.dtype)
        return (jnp.einsum('bkgqj,bjkd->bqkgd', p[..., :span], vw)
                + jnp.einsum('bkgqj,bjkd->bqkgd', p[..., span:span + L], v_ctx))

    o = lax.map(one, (jnp.arange(nb), qb))
    return jnp.moveaxis(o, 0, 1).reshape(B, S, Hq * hd)


def centred_conv(z, w, b):
    S = z.shape[1]
    zp = jnp.pad(z, ((0, 0), (CONV_LEFT, CONV_RIGHT), (0, 0)))
    y = b
    for tap in range(CONV_W):
        y = y + zp[:, tap:tap + S] * w[tap]
    return y


def linear_scan(a, b, h0, reverse):
    def comb(l, r):
        return (l[0] * r[0], r[0] * l[1] + r[1])
    A, Bc = lax.associative_scan(comb, (a, b), axis=1, reverse=reverse)
    return A * h0[:, None, :] + Bc


def rglru_direction(u, wa, ba, wx, bx, lam, h0, reverse):
    B, S, W = u.shape
    ub = u.reshape(B, S, LRU_BLOCKS, LRU_BW)
    r = jax.nn.sigmoid((jnp.einsum('bsnc,ncd->bsnd', ub, wa).reshape(B, S, W) + ba).astype(jnp.float32))
    i = jax.nn.sigmoid((jnp.einsum('bsnc,ncd->bsnd', ub, wx).reshape(B, S, W) + bx).astype(jnp.float32))
    log_a = -LRU_C * r * jax.nn.softplus(-lam.astype(jnp.float32))
    a = jnp.exp(log_a)
    bt = jnp.sqrt(-jnp.expm1(2.0 * log_a)) * (i * u.astype(jnp.float32))
    return linear_scan(a, bt, h0, reverse)


def merge_groups(o_mla, o_swa, o_lru, g):
    return jnp.concatenate([
        rmsnorm(o_mla, g[:MLA_OUT]),
        rmsnorm(o_swa, g[MLA_OUT:MLA_OUT + SWA_OUT]),
        rmsnorm(o_lru, g[MLA_OUT + SWA_OUT:]),
    ], axis=-1)


def mixing_layer(h, hc, rows, cols, w_in, g_cq, w_uq, g_ckv, w_ukv, sink, conv_w, conv_b,
                 wa, ba, wx, bx, lam, g_grp, w_out, need_ctx_out):
    B, S, _ = h.shape
    L = hc.shape[1]
    z = split_cols(h @ w_in)
    zc = split_cols(hc @ w_in)
    k_c, v_c = mla_kv(zc[1], zc[2], g_ckv, w_ukv, None, None)
    sk_c = zc[4].reshape(B, L, SWA_KV_HEADS, SWA_HEAD_DIM)
    sv_c = zc[5].reshape(B, L, SWA_KV_HEADS, SWA_HEAD_DIM)
    u_c = centred_conv(zc[6], conv_w, conv_b)
    h0 = jnp.zeros((B, LRU_WIDTH), jnp.float32)
    hf_c = rglru_direction(u_c, wa[0], ba[0], wx[0], bx[0], lam[0], h0, False)
    hb_c = rglru_direction(u_c, wa[1], ba[1], wx[1], bx[1], lam[1], h0, True)
    q = mla_q(z[0], g_cq, w_uq, rows, cols)
    k, v = mla_kv(z[1], z[2], g_ckv, w_ukv, rows, cols)
    o_mla = blockwise_attention(q, jnp.concatenate([k_c, k], axis=1), jnp.concatenate([v_c, v], axis=1), MLA_SCALE)
    sq = rope_2d(z[3].reshape(B, S, SWA_HEADS, SWA_HEAD_DIM), rows, cols)
    sk = rope_2d(z[4].reshape(B, S, SWA_KV_HEADS, SWA_HEAD_DIM), rows, cols)
    sv = z[5].reshape(B, S, SWA_KV_HEADS, SWA_HEAD_DIM)
    o_swa = banded_sink_attention(sq, sk, sv, sk_c, sv_c, sink)
    u = centred_conv(z[6], conv_w, conv_b)
    hf = rglru_direction(u, wa[0], ba[0], wx[0], bx[0], lam[0], hf_c[:, -1], False)
    hb = rglru_direction(u, wa[1], ba[1], wx[1], bx[1], lam[1], hb_c[:, 0], True)
    o_lru = (hf + hb).astype(h.dtype) * jax.nn.gelu(z[7])
    out = merge_groups(o_mla, o_swa, o_lru, g_grp) @ w_out
    if not need_ctx_out:
        return out, None
    q_c = mla_q(zc[0], g_cq, w_uq, None, None)
    oc_mla = dense_attention(q_c, k_c, v_c, MLA_SCALE)
    oc_swa = sink_attention(zc[3].reshape(B, L, SWA_HEADS, SWA_HEAD_DIM), sk_c, sv_c, sink)
    oc_lru = (hf_c + hb_c).astype(hc.dtype) * jax.nn.gelu(zc[7])
    out_c = merge_groups(oc_mla, oc_swa, oc_lru, g_grp) @ w_out
    return out, out_c


def hmoe(h, w_g1, b_g1, w_g2, b_g2, w_eg, w_eu, w_ed):
    shp = h.shape
    t = h.reshape(-1, shp[-1])
    T = t.shape[0]
    pg = jax.nn.softmax((t @ w_g1 + b_g1).astype(jnp.float32), axis=-1)
    pg_top, g_idx = lax.top_k(pg, 1)
    le = jnp.einsum('td,gde->tge', t, w_g2) + b_g2
    le_sel = le[jnp.arange(T), g_idx[:, 0]]
    pe = jax.nn.softmax(le_sel.astype(jnp.float32), axis=-1)
    pe_top, e_idx = lax.top_k(pe, TOP_K)
    w = pg_top * pe_top / jnp.sum(pe_top, axis=-1, keepdims=True)
    eid = g_idx * EXPERTS_PER_GROUP + e_idx
    combine = jnp.sum(jax.nn.one_hot(eid, N_EXPERTS, dtype=jnp.float32) * w[..., None], axis=1).astype(t.dtype)
    y = jnp.zeros_like(t)
    for e in range(N_EXPERTS):
        act = jax.nn.silu(t @ w_eg[e]) * (t @ w_eu[e])
        y = y + (combine[:, e:e + 1] * act) @ w_ed[e]
    return y.reshape(shp)


def setup_inputs(seed: int = 0) -> dict:
    key = jax.random.key(seed)
    ks = iter(jax.random.split(key, 40))
    f32 = jnp.float32

    def nrm(shape, scale):
        return jax.random.normal(next(ks), shape, f32) * scale

    def gain(shape):
        return 1.0 + nrm(shape, 0.01)

    u = jax.random.uniform(next(ks), (DEPTH, 2, LRU_WIDTH), f32, minval=0.9, maxval=0.999)
    a0 = u ** (1.0 / LRU_C)
    lru_lam = jnp.log(a0) - jnp.log1p(-a0)
    return {
        'x': nrm((BATCH, SEQ, D_MODEL), 1.0),
        'c': nrm((BATCH, D_MODEL), 1.0),
        'ctx': nrm((BATCH, CTX_LEN, D_MODEL), 1.0),
        'c_ctx': nrm((D_MODEL,), 1.0),
        'w_ada': nrm((DEPTH, D_MODEL, 6 * D_MODEL), 0.5 * D_MODEL ** -0.5),
        'b_ada': nrm((DEPTH, 6 * D_MODEL), 0.01),
        'g_norm1': gain((DEPTH, D_MODEL)),
        'g_norm2': gain((DEPTH, D_MODEL)),
        'w_in': nrm((DEPTH, D_MODEL, IN_COLS), D_MODEL ** -0.5),
        'g_cq': gain((DEPTH, MLA_Q_RANK)),
        'w_uq': nrm((DEPTH, MLA_Q_RANK, MLA_HEADS * (MLA_NOPE + MLA_ROPE)), MLA_Q_RANK ** -0.5),
        'g_ckv': gain((DEPTH, MLA_KV_RANK)),
        'w_ukv': nrm((DEPTH, MLA_KV_RANK, MLA_HEADS * (MLA_NOPE + MLA_V)), MLA_KV_RANK ** -0.5),
        'swa_sink': nrm((DEPTH, SWA_HEADS), 1.0),
        'conv_w': nrm((DEPTH, CONV_W, LRU_WIDTH), CONV_W ** -0.5),
        'conv_b': nrm((DEPTH, LRU_WIDTH), 0.01),
        'lru_wa': nrm((DEPTH, 2, LRU_BLOCKS, LRU_BW, LRU_BW), LRU_BW ** -0.5),
        'lru_ba': nrm((DEPTH, 2, LRU_WIDTH), 0.01),
        'lru_wx': nrm((DEPTH, 2, LRU_BLOCKS, LRU_BW, LRU_BW), LRU_BW ** -0.5),
        'lru_bx': nrm((DEPTH, 2, LRU_WIDTH), 0.01),
        'lru_lam': lru_lam,
        'g_grp': gain((DEPTH, MIX_WIDTH)),
        'w_out': nrm((DEPTH, MIX_WIDTH, D_MODEL), MIX_WIDTH ** -0.5),
        'w_g1': nrm((DEPTH, D_MODEL, N_GROUPS), D_MODEL ** -0.5),
        'b_g1': nrm((DEPTH, N_GROUPS), 0.01),
        'w_g2': nrm((DEPTH, N_GROUPS, D_MODEL, EXPERTS_PER_GROUP), D_MODEL ** -0.5),
        'b_g2': nrm((DEPTH, N_GROUPS, EXPERTS_PER_GROUP), 0.01),
        'w_e_gate': nrm((DEPTH, N_EXPERTS, D_MODEL, D_EXPERT), D_MODEL ** -0.5),
        'w_e_up': nrm((DEPTH, N_EXPERTS, D_MODEL, D_EXPERT), D_MODEL ** -0.5),
        'w_e_down': nrm((DEPTH, N_EXPERTS, D_EXPERT, D_MODEL), D_EXPERT ** -0.5),
        'g_final': gain((D_MODEL,)),
    }


def reference(x, c, ctx, c_ctx, w_ada, b_ada, g_norm1, g_norm2, w_in, g_cq, w_uq, g_ckv, w_ukv,
              swa_sink, conv_w, conv_b, lru_wa, lru_ba, lru_wx, lru_bx, lru_lam, g_grp, w_out,
              w_g1, b_g1, w_g2, b_g2, w_e_gate, w_e_up, w_e_down, g_final):
    S = x.shape[1]
    ROWS = S // GRID_W
    rows = jnp.repeat(jnp.arange(ROWS, dtype=jnp.int32), GRID_W)
    cols = jnp.tile(jnp.arange(GRID_W, dtype=jnp.int32), ROWS)
    xc = ctx
    for l in range(DEPTH):
        last = l == DEPTH - 1
        mod = (jax.nn.silu(c) @ w_ada[l] + b_ada[l])[:, None, :]
        mod_c = jax.nn.silu(c_ctx) @ w_ada[l] + b_ada[l]
        sh1, sc1, gt1, sh2, sc2, gt2 = jnp.split(mod, 6, axis=-1)
        sh1c, sc1c, gt1c, sh2c, sc2c, gt2c = jnp.split(mod_c, 6, axis=-1)
        h = rmsnorm(x, g_norm1[l]) * (1.0 + sc1) + sh1
        hc = rmsnorm(xc, g_norm1[l]) * (1.0 + sc1c) + sh1c
        mix, mix_c = mixing_layer(h, hc, rows, cols, w_in[l], g_cq[l], w_uq[l], g_ckv[l], w_ukv[l],
                                  swa_sink[l], conv_w[l], conv_b[l], lru_wa[l], lru_ba[l], lru_wx[l],
                                  lru_bx[l], lru_lam[l], g_grp[l], w_out[l], not last)
        x = x + gt1 * mix
        h2 = rmsnorm(x, g_norm2[l]) * (1.0 + sc2) + sh2
        x = x + gt2 * hmoe(h2, w_g1[l], b_g1[l], w_g2[l], b_g2[l], w_e_gate[l], w_e_up[l], w_e_down[l])
        if not last:
            xc = xc + gt1c * mix_c
            h2c = rmsnorm(xc, g_norm2[l]) * (1.0 + sc2c) + sh2c
            xc = xc + gt2c * hmoe(h2c, w_g1[l], b_g1[l], w_g2[l], b_g2[l], w_e_gate[l], w_e_up[l], w_e_down[l])
    return rmsnorm(x, g_final)
```

```cpp
#ifndef EMU
#include <hip/hip_runtime.h>
#endif
#include <cstdint>
#include <cstdio>
#include <type_traits>

#ifndef CFG_TINY
constexpr int D = 1024, NB = 16, S = 4096, LC = 256, DEPTH = 2;
#else
constexpr int D = 256, NB = 2, S = 768, LC = 256, DEPTH = 2;
#endif
constexpr int GW = 64;
constexpr int J = LC + S;
constexpr int R = NB * J;
constexpr int INC = 1952;
constexpr int C_CQ = 0, C_CKV = 256, C_KR = 384, C_SQ = 416, C_SK = 672, C_SV = 800, C_LX = 928, C_LG = 1440;
constexpr int MIXW = 1024;
constexpr int NPAIR = 112;
constexpr int DE = 256;
#ifndef PROBE
#define PROBE 0
#endif
constexpr float EPS = 1e-6f;
constexpr float LOG2E = 1.4426950408889634f;
constexpr int NTHREADS = 256;
static_assert(J % 256 == 0 && LC % 256 == 0 && S % 64 == 0 && D % 64 == 0, "tile divisibility");

typedef unsigned short bf16_t;
#ifndef EMU
typedef short bf16x8 __attribute__((ext_vector_type(8)));
typedef float f32x4 __attribute__((ext_vector_type(4)));
typedef float f32x16 __attribute__((ext_vector_type(16)));
#endif
typedef unsigned u32x4 __attribute__((ext_vector_type(4)));
typedef unsigned u32x2 __attribute__((ext_vector_type(2)));
typedef float f32x2 __attribute__((ext_vector_type(2)));

constexpr size_t al256(size_t x) { return (x + 255) & ~(size_t)255; }
constexpr int XCD_BAR_WORDS_C = 3456;
constexpr size_t WS_BAR = 0;
constexpr size_t WS_CNT = al256(WS_BAR + XCD_BAR_WORDS_C * 4);
constexpr size_t WS_ZROW = al256(WS_CNT + DEPTH * 128 * 4);
constexpr size_t WS_ZERO_BYTES = al256(WS_ZROW + 4096);
constexpr size_t WS_MOD = WS_ZERO_BYTES;
constexpr size_t WS_ROPE = al256(WS_MOD + (size_t)DEPTH * 17 * 6 * D * 4);
constexpr size_t WS_WIN = al256(WS_ROPE + (64 * 16 * 2 + 64 * 8 * 2) * 4);
constexpr size_t WS_WUQ = al256(WS_WIN + (size_t)DEPTH * 2048 * D * 2);
constexpr size_t WS_WUKV = al256(WS_WUQ + (size_t)DEPTH * 384 * 256 * 2);
constexpr size_t WS_WOUT = al256(WS_WUKV + (size_t)DEPTH * 512 * 128 * 2);
constexpr size_t WS_WLRU = al256(WS_WOUT + (size_t)DEPTH * D * MIXW * 2);
constexpr size_t WS_WRT = al256(WS_WLRU + (size_t)DEPTH * 8 * 2 * 4 * 2 * 4096 * 2);
constexpr size_t WS_WEG = al256(WS_WRT + (size_t)DEPTH * 64 * D * 2);
constexpr size_t WS_WEU = al256(WS_WEG + (size_t)DEPTH * 32 * DE * D * 2);
constexpr size_t WS_WED = al256(WS_WEU + (size_t)DEPTH * 32 * DE * D * 2);
constexpr size_t WS_X = al256(WS_WED + (size_t)DEPTH * 32 * D * DE * 2);
constexpr size_t WS_H = al256(WS_X + (size_t)R * D * 2);
constexpr size_t WS_Z = al256(WS_H + (size_t)R * (D > MIXW ? D : MIXW) * 2);
constexpr int ACT_ROWS = R + NPAIR * 128;
constexpr size_t Z_BYTES = (size_t)R * INC * 2 > (size_t)ACT_ROWS * 512 * 2 ? (size_t)R * INC * 2 : (size_t)ACT_ROWS * 512 * 2;
constexpr size_t WS_ZSS = al256(WS_Z + Z_BYTES);
constexpr size_t WS_Q = al256(WS_ZSS + (size_t)R * 8 * 4);
constexpr size_t WS_KN = al256(WS_Q + (size_t)NB * 4 * J * 96 * 2);
constexpr size_t WS_KR = al256(WS_KN + (size_t)NB * 4 * J * 64 * 2);
constexpr size_t WS_VT = al256(WS_KR + (size_t)NB * J * 32 * 2);
constexpr size_t WS_SQ = al256(WS_VT + (size_t)NB * 4 * 64 * J * 2);
constexpr size_t WS_SK = al256(WS_SQ + (size_t)NB * 4 * J * 64 * 2);
constexpr size_t WS_SVT = al256(WS_SK + (size_t)NB * 2 * J * 64 * 2);
constexpr int SSW = 40;
constexpr size_t WS_SS = al256(WS_SVT + (size_t)NB * 2 * 64 * J * 2);
constexpr size_t WS_HF = al256(WS_SS + (size_t)R * SSW * 4);
constexpr size_t WS_LIST = al256(WS_HF + (size_t)NB * 512 * J * 2);
constexpr size_t WS_LW = al256(WS_LIST + (size_t)NPAIR * R * 4);
constexpr size_t WS_END = al256(WS_LW + (size_t)R * 2 * 4);
static_assert(WS_END <= ((size_t)1 << 30), "workspace = 4 x the output");

struct Params {
    const float* in[31];
    float* out;
    unsigned char* ws;
};

#ifdef EMU
#define GLDS16(gp, lp) memcpy((void*)(lp), (const void*)(gp), 16)
#define WAIT_VM(n) do {} while (0)
#define RAW_BARRIER() emu_block_barrier()
#define SETPRIO(n) do {} while (0)
#define SCHED_FENCE() do {} while (0)
#define PIN1(a) do {} while (0)
#define PIN2(a, b) do {} while (0)
#define MFMA16(a, b, c) emu_mfma16(a, b, c)
#define MFMA32(a, b, c) emu_mfma32(a, b, c)
#define SMEM_PTR() emu_lds()
static inline float fast_exp2(float x) { return exp2f(x); }
static inline float fast_rcp(float x) { return 1.0f / x; }
static inline float fast_rsqrt(float x) { return 1.0f / sqrtf(x); }
static inline float fast_sqrt(float x) { return sqrtf(x); }
#else
#define GLDS16(gp, lp) __builtin_amdgcn_global_load_lds((const __attribute__((address_space(1))) unsigned*)(gp), (__attribute__((address_space(3))) unsigned*)(lp), 16, 0, 0)
#define WAIT_VM(n) asm volatile("s_waitcnt vmcnt(" #n ")" ::: "memory")
#define RAW_BARRIER() do { asm volatile("" ::: "memory"); __builtin_amdgcn_s_barrier(); asm volatile("" ::: "memory"); } while (0)
#define SCHED_FENCE() __builtin_amdgcn_sched_barrier(0)
#define SETPRIO(n) __builtin_amdgcn_s_setprio(n)
#define PIN1(a) asm volatile("" : "+v"(a))
#define PIN2(a, b) asm volatile("" : "+v"(a), "+v"(b))
#define MFMA16(a, b, c) __builtin_amdgcn_mfma_f32_16x16x32_bf16(a, b, c, 0, 0, 0)
#define MFMA32(a, b, c) __builtin_amdgcn_mfma_f32_32x32x16_bf16(a, b, c, 0, 0, 0)
extern __shared__ __attribute__((aligned(16))) unsigned char smem_raw[];
#define SMEM_PTR() smem_raw
__device__ __forceinline__ float fast_exp2(float x) { return __builtin_amdgcn_exp2f(x); }
__device__ __forceinline__ float fast_rcp(float x) { return __builtin_amdgcn_rcpf(x); }
__device__ __forceinline__ float fast_rsqrt(float x) { return __builtin_amdgcn_rsqf(x); }
__device__ __forceinline__ float fast_sqrt(float x) { return __builtin_amdgcn_sqrtf(x); }
#endif

#ifdef EMU
__device__ __forceinline__ bf16_t f2bf(float f) {
    unsigned u = __builtin_bit_cast(unsigned, f);
    u += 0x7FFFu + ((u >> 16) & 1u);
    return (bf16_t)(u >> 16);
}
__device__ __forceinline__ unsigned pack2(float lo, float hi) { return (unsigned)f2bf(lo) | ((unsigned)f2bf(hi) << 16); }
#else
typedef __bf16 bf16x2_t __attribute__((ext_vector_type(2)));
__device__ __forceinline__ bf16_t f2bf(float f) { return __builtin_bit_cast(bf16_t, (__bf16)f); }
__device__ __forceinline__ unsigned pack2(float lo, float hi) { bf16x2_t v; v[0] = (__bf16)lo; v[1] = (__bf16)hi; return __builtin_bit_cast(unsigned, v); }
#endif
__device__ __forceinline__ float bf2f(bf16_t h) { return __builtin_bit_cast(float, ((unsigned)h) << 16); }
__device__ __forceinline__ float sigmoidf_(float x) { return fast_rcp(1.0f + fast_exp2(-x * LOG2E)); }
__device__ __forceinline__ float siluf_(float x) { return x * sigmoidf_(x); }
__device__ __forceinline__ float gelu_tanh(float x) {
    const float u = 0.7978845608028654f * (x + 0.044715f * x * x * x);
    const float t = 1.0f - 2.0f * fast_rcp(fast_exp2(2.0f * LOG2E * u) + 1.0f);
    return 0.5f * x * (1.0f + t);
}

#ifdef EMU
static inline int tidx() { return (int)threadIdx.x; }
#else
__device__ __forceinline__ int tidx() { int t = threadIdx.x; asm volatile("" : "+v"(t)); return t; }
#endif

__device__ __forceinline__ const float* xin_row(const Params& p, int row) {
    const int b = row / J, j = row - b * J;
    return j < LC ? p.in[2] + ((size_t)b * LC + j) * D : p.in[0] + ((size_t)b * S + (j - LC)) * D;
}
__device__ __forceinline__ bf16_t* xrow(const Params& p, int row) { return (bf16_t*)(p.ws + WS_X) + (size_t)row * D; }
__device__ __forceinline__ f32x4 xload4(const Params& p, int layer, int row, int col) {
    if (layer == 0) return *(const f32x4*)(xin_row(p, row) + col);
    const u32x2 w = *(const u32x2*)(xrow(p, row) + col);
    return (f32x4){bf2f((bf16_t)(w[0] & 0xffff)), bf2f((bf16_t)(w[0] >> 16)), bf2f((bf16_t)(w[1] & 0xffff)), bf2f((bf16_t)(w[1] >> 16))};
}
__device__ __forceinline__ f32x4 xload4s(const Params& p, int row, int col) {
    const u32x2 w = *(const u32x2*)(xrow(p, row) + col);
    return (f32x4){bf2f((bf16_t)(w[0] & 0xffff)), bf2f((bf16_t)(w[0] >> 16)), bf2f((bf16_t)(w[1] & 0xffff)), bf2f((bf16_t)(w[1] >> 16))};
}
__device__ __forceinline__ void xstore4(const Params& p, int row, int col, f32x4 v) { *(u32x2*)(xrow(p, row) + col) = (u32x2){pack2(v[0], v[1]), pack2(v[2], v[3])}; }
__device__ __forceinline__ int mod_index(int row) { const int b = row / J, j = row - b * J; return j < LC ? NB : b; }
__device__ __forceinline__ const float* mod_ptr(const Params& p, int layer, int mi, int which) {
    return (const float*)(p.ws + WS_MOD) + ((size_t)(layer * 17 + mi) * 6 + which) * D;
}

template <bool FROM_IN>
__device__ __forceinline__ void resid8(const Params& p, int layer, int row, int col, const float* gt, f32x4 lo, f32x4 hi) {
    f32x4 x0, x1;
    if (FROM_IN && layer == 0) { x0 = *(const f32x4*)(xin_row(p, row) + col); x1 = *(const f32x4*)(xin_row(p, row) + col + 4); }
    else { const u32x4 w = *(const u32x4*)(xrow(p, row) + col);
        x0 = (f32x4){__builtin_bit_cast(float, w[0] << 16), __builtin_bit_cast(float, w[0] & 0xffff0000u), __builtin_bit_cast(float, w[1] << 16), __builtin_bit_cast(float, w[1] & 0xffff0000u)};
        x1 = (f32x4){__builtin_bit_cast(float, w[2] << 16), __builtin_bit_cast(float, w[2] & 0xffff0000u), __builtin_bit_cast(float, w[3] << 16), __builtin_bit_cast(float, w[3] & 0xffff0000u)}; }
    const f32x4 g0 = *(const f32x4*)(gt + col), g1 = *(const f32x4*)(gt + col + 4);
    const f32x4 o0 = x0 + g0 * lo, o1 = x1 + g1 * hi;
    *(u32x4*)(xrow(p, row) + col) = (u32x4){pack2(o0[0], o0[1]), pack2(o0[2], o0[3]), pack2(o1[0], o1[1]), pack2(o1[2], o1[3])};
}

__device__ __forceinline__ void swap16(unsigned& a, unsigned& b) {
#ifdef EMU
    const int l_ = emu_lane(); const unsigned pa = emu_shfl_u(a, l_ ^ 16), pb = emu_shfl_u(b, l_ ^ 16);
    if ((l_ >> 4) & 1) a = pb; else b = pa;
#else
    const auto r = __builtin_amdgcn_permlane16_swap(a, b, false, false); a = r[0]; b = r[1];
#endif
}
__device__ __forceinline__ void swap32(unsigned& a, unsigned& b) {
#ifdef EMU
    const int l_ = emu_lane(); const unsigned pa = emu_shfl_u(a, l_ ^ 32), pb = emu_shfl_u(b, l_ ^ 32);
    if (l_ >> 5) a = pb; else b = pa;
#else
    const auto r = __builtin_amdgcn_permlane32_swap(a, b, false, false); a = r[0]; b = r[1];
#endif
}
__device__ __forceinline__ u32x4 widen_pair32(u32x2 A, u32x2 B) { unsigned a0 = A[0], a1 = A[1], b0 = B[0], b1 = B[1]; swap32(a0, b0); swap32(a1, b1); return (u32x4){a0, a1, b0, b1}; }
__device__ __forceinline__ u32x4 widen_pair(u32x2 A, u32x2 B) { unsigned a0 = A[0], a1 = A[1], b0 = B[0], b1 = B[1]; swap16(a0, b0); swap16(a1, b1); return (u32x4){a0, a1, b0, b1}; }
__device__ __forceinline__ void widen_acc(f32x4& a, f32x4& b) {
#pragma unroll
    for (int e = 0; e < 4; ++e) { const float fa = a[e], fb = b[e]; unsigned ua = __builtin_bit_cast(unsigned, fa), ub = __builtin_bit_cast(unsigned, fb); swap16(ua, ub);
        const float ra = __builtin_bit_cast(float, ua), rb = __builtin_bit_cast(float, ub); a[e] = ra; b[e] = rb; }
}
struct NoGS { template <class T> __device__ __forceinline__ float operator()(T, int) const { return 1.f; } };
template <int WN, bool GS, class AP, class BP, class BP2, class GSF, class EPI>
__device__ __forceinline__ void gemm_tile(const AP& ap, const BP& bp, const BP2& bp2, const int K, const int ksplit, unsigned char* lds, const GSF& gsf, const EPI& epi) {
    constexpr int NBP = WN;
    const int tid = tidx(), lane = tid & 63, wid = tid >> 6, wr = wid >> 1, wc = wid & 1, fr = lane & 15, fq = lane >> 4;
    const int lr = tid >> 3, ch = tid & 7;
    const bf16_t* aptr[4]; const bf16_t* bptr[NBP]; const bf16_t* bptr2[NBP];
#pragma unroll
    for (int i = 0; i < 4; ++i) aptr[i] = ap(lr + 32 * i) + ch * 8;
#pragma unroll
    for (int i = 0; i < NBP; ++i) { bptr[i] = bp(lr + 32 * i) + ch * 8; bptr2[i] = bp2(lr + 32 * i) + ch * 8 - ksplit * 64; }
    const int wofs = lr * 128 + ((ch ^ (lr & 7)) << 4);
    f32x4 acc[4][WN];
#pragma unroll
    for (int mi = 0; mi < 4; ++mi)
#pragma unroll
        for (int ni = 0; ni < WN; ++ni) acc[mi][ni] = (f32x4){0.f, 0.f, 0.f, 0.f};
    const int KT = K / 64;
    u32x4 ra0[4], rb0[NBP], ra1[4], rb1[NBP];
    auto gl = [&](u32x4 (&ra)[4], u32x4 (&rb)[NBP], int kt) {
#pragma unroll
        for (int i = 0; i < 4; ++i) ra[i] = *(const u32x4*)(aptr[i] + kt * 64);
#pragma unroll
        for (int i = 0; i < NBP; ++i) { const bf16_t* q = (kt < ksplit) ? bptr[i] : bptr2[i]; rb[i] = *(const u32x4*)(q + kt * 64); }
    };
    auto sw = [&](const u32x4 (&ra)[4], const u32x4 (&rb)[NBP], int st) {
#pragma unroll
        for (int i = 0; i < 4; ++i) *(u32x4*)(lds + st * 16384 + wofs + i * 4096) = ra[i];
#pragma unroll
        for (int i = 0; i < NBP; ++i) *(u32x4*)(lds + 32768 + st * 16384 + wofs + i * 4096) = rb[i];
    };
    auto compute = [&](int st, int kt) {
        const unsigned char* As = lds + st * 16384;
        const unsigned char* Bs = lds + 32768 + st * 16384;
#pragma unroll
        for (int ks = 0; ks < 2; ++ks) {
            bf16x8 af[4], bfr[WN];
            const int sw_ = ((ks * 4 + fq) ^ (fr & 7)) << 4;
#pragma unroll
            for (int mi = 0; mi < 4; ++mi) af[mi] = *(const bf16x8*)(As + (wr * 64 + mi * 16 + fr) * 128 + sw_);
#pragma unroll
            for (int ni = 0; ni < WN; ++ni) bfr[ni] = *(const bf16x8*)(Bs + (wc * 16 * WN + ni * 16 + fr) * 128 + sw_);
            SETPRIO(1);
#pragma unroll
            for (int mi = 0; mi < 4; ++mi)
#pragma unroll
                for (int ni = 0; ni < WN; ++ni) acc[mi][ni] = MFMA16(bfr[ni], af[mi], acc[mi][ni]);
            SETPRIO(0);
        }
        if (GS) {
            auto scale = [&](auto gtag) {
#pragma unroll
                for (int mi = 0; mi < 4; ++mi) { const float sc = gsf(gtag, mi);
#pragma unroll
                    for (int ni = 0; ni < WN; ++ni) acc[mi][ni] *= sc; }
            };
            if (kt == 3) scale(std::integral_constant<int, 0>());
            else if (kt == 7) scale(std::integral_constant<int, 1>());
            else if (kt == KT - 1) scale(std::integral_constant<int, 2>());
        }
    };
    gl(ra0, rb0, 0);
    if (KT > 1) gl(ra1, rb1, 1);
    sw(ra0, rb0, 0);
    if (KT > 2) gl(ra0, rb0, 2);
    __syncthreads();
    for (int kt = 0; kt < KT; kt += 2) {
        compute(0, kt);
        if (kt + 1 < KT) { sw(ra1, rb1, 1); if (kt + 3 < KT) gl(ra1, rb1, kt + 3); }
        __syncthreads();
        if (kt + 1 < KT) {
            compute(1, kt + 1);
            if (kt + 2 < KT) { sw(ra0, rb0, 0); if (kt + 4 < KT) gl(ra0, rb0, kt + 4); }
            __syncthreads();
        }
    }
    epi(acc, wr, wc, fr, fq);
}

__device__ __forceinline__ int swz4(int row) { return (0x78 >> (((row >> 2) & 3) * 2)) & 3; }
template <bool GS, class AP, class BP, class BP2, class GSF, class EPI>
__device__ __forceinline__ void gemm_tile2(const AP& ap, const BP& bp, const BP2& bp2, const int K, const int ksplit, unsigned char* lds, const GSF& gsf, const EPI& epi) {
    const int tid = tidx(), lane = tid & 63, wid = tid >> 6, wr = wid >> 1, wc = wid & 1, fr = lane & 15, fq = lane >> 4;
    const int rl = lane >> 2, cp = lane & 3;
    const bf16_t* asrc[2]; const bf16_t* bsrc[4]; const bf16_t* bsrc2[4];
#pragma unroll
    for (int i = 0; i < 2; ++i) { const int row = (2 * wid + i) * 16 + rl; asrc[i] = ap(row) + ((cp ^ swz4(row)) << 3); }
#pragma unroll
    for (int i = 0; i < 4; ++i) { const int row = (4 * wid + i) * 16 + rl; bsrc[i] = bp(row) + ((cp ^ swz4(row)) << 3); bsrc2[i] = bp2(row) + ((cp ^ swz4(row)) << 3) - ksplit * 32; }
    unsigned char* const dstA = lds + (2 * wid) * 1024 + lane * 16;
    unsigned char* const dstB = lds + 8192 + (4 * wid) * 1024 + lane * 16;
    auto issue = [&](int kt, int st) {
#pragma unroll
        for (int i = 0; i < 2; ++i) GLDS16(asrc[i] + kt * 32, dstA + st * 24576 + i * 1024);
#pragma unroll
        for (int i = 0; i < 4; ++i) GLDS16((kt < ksplit ? bsrc[i] : bsrc2[i]) + kt * 32, dstB + st * 24576 + i * 1024);
    };
    f32x4 acc[4][8];
#pragma unroll
    for (int mi = 0; mi < 4; ++mi)
#pragma unroll
        for (int ni = 0; ni < 8; ++ni) acc[mi][ni] = (f32x4){0.f, 0.f, 0.f, 0.f};
    const int KT = K / 32;
    const int rdo = ((fq ^ swz4(fr)) << 4) + fr * 64;
    issue(0, 0); issue(1, 1);
    int st = 0;
#pragma unroll 1
    for (int kt = 0; kt < KT; ++kt) {
        if (kt + 1 < KT) WAIT_VM(6); else WAIT_VM(0);
        RAW_BARRIER();
        const unsigned char* As = lds + st * 24576 + (wr * 64) * 64 + rdo;
        const unsigned char* Bs = lds + st * 24576 + 8192 + (wc * 128) * 64 + rdo;
        bf16x8 af[4], bfr[8];
#pragma unroll
        for (int mi = 0; mi < 4; ++mi) af[mi] = *(const bf16x8*)(As + mi * 1024);
#pragma unroll
        for (int ni = 0; ni < 8; ++ni) bfr[ni] = *(const bf16x8*)(Bs + ni * 1024);
        SETPRIO(1);
#pragma unroll
        for (int ni = 0; ni < 8; ++ni)
#pragma unroll
            for (int mi = 0; mi < 4; ++mi) acc[mi][ni] = MFMA16(bfr[ni], af[mi], acc[mi][ni]);
        SETPRIO(0);
        if (GS) {
            auto scale = [&](auto gtag) {
#pragma unroll
                for (int mi = 0; mi < 4; ++mi) { const float sc = gsf(gtag, mi);
#pragma unroll
                    for (int ni = 0; ni < 8; ++ni) acc[mi][ni] *= sc; }
            };
            if (kt == 7) scale(std::integral_constant<int, 0>());
            else if (kt == 15) scale(std::integral_constant<int, 1>());
            else if (kt == KT - 1) scale(std::integral_constant<int, 2>());
        }
        if (kt + 2 < KT) issue(kt + 2, st >= 1 ? st - 1 : 2);
        st = st == 2 ? 0 : st + 1;
    }
    RAW_BARRIER();
    { const int tz = tidx(), lz = tz & 63, wz = tz >> 6;
      epi(acc, wz >> 1, wz & 1, lz & 15, lz >> 4); }
}

#ifdef EMU
static inline float xhalf_max2(float v, float) { const float pv = __shfl_xor(v, 32); return (emu_lane() & 32) ? pv : v; }
#else
__device__ __forceinline__ float xhalf_max2(float v, float other) {
    const auto r = __builtin_amdgcn_permlane32_swap(__builtin_bit_cast(unsigned, other), __builtin_bit_cast(unsigned, v), false, false);
    return (threadIdx.x & 32) ? __builtin_bit_cast(float, r[0]) : v; }
#endif
struct AttnArgs {
    const bf16_t* q;
    const bf16_t* kn;
    const bf16_t* kr;
    const bf16_t* vt;
    int n1;
    int jlo, jhi;
    int tq;
    float sink2;
    bf16_t* o;
    float* ss;
};
template <bool MLA>
__device__ __forceinline__ void attn_unit(const AttnArgs& a, unsigned char* lds) {
    constexpr int NKS = MLA ? 6 : 4;
    const int tid = tidx(), lane = tid & 63, r = lane & 31, h = lane >> 5;
    const int kap = (r & ~12) | ((r & 4) << 1) | ((r & 8) >> 1);
    bf16x8 qf[NKS];
#pragma unroll
    for (int ks = 0; ks < NKS; ++ks) qf[ks] = *(const bf16x8*)(a.q + ks * 16 + h * 8);
    f32x16 o0, o1;
#pragma unroll
    for (int e = 0; e < 16; ++e) { o0[e] = 0.f; o1[e] = 0.f; }
    float m = -1e30f, l = 0.f;
    const int ntl = a.n1 + (a.jhi > a.jlo ? (a.jhi - a.jlo) / 64 : 0);
    const int wv = tid >> 6;
    int okn[2], ovt[2];
#pragma unroll
    for (int q = 0; q < 2; ++q) { const int row = (2 * wv + q) * 8 + (lane >> 3), sw = ((lane & 7) ^ ((row >> 1) & 7)) * 8; okn[q] = row * 64 + sw; ovt[q] = row * J + sw; }
    const int krow = 16 * wv + (lane >> 2), okr = krow * 32 + (((lane & 3) ^ ((krow >> 2) & 3)) * 8);
    auto tile_j0 = [&](int i) { return i < a.n1 ? 64 * i : a.jlo + 64 * (i - a.n1); };
    auto issue = [&](int j, int st) {
        const int jk = tile_j0(j + 1 < ntl ? j + 1 : ntl - 1), jv = tile_j0(j > 0 ? j - 1 : 0);
        unsigned char* b = lds + st * 20480 + lane * 16;
#pragma unroll
        for (int q = 0; q < 2; ++q) GLDS16(a.kn + (size_t)jk * 64 + okn[q], b + (2 * wv + q) * 1024);
#pragma unroll
        for (int q = 0; q < 2; ++q) GLDS16(a.vt + jv + ovt[q], b + 8192 + (2 * wv + q) * 1024);
        if (MLA) GLDS16(a.kr + (size_t)jk * 32 + okr, b + 16384 + wv * 1024);
    };
    auto qk = [&](int st, f32x16& s0, f32x16& s1) {
        const unsigned char* b = lds + st * 20480;
#pragma unroll
        for (int e = 0; e < 16; ++e) { s0[e] = 0.f; s1[e] = 0.f; }
#pragma unroll
        for (int ks = 0; ks < NKS; ++ks) {
            bf16x8 k0, k1;
            if (ks < 4) {
                const int row0 = kap, row1 = 32 + kap, c = 2 * ks + h;
                k0 = *(const bf16x8*)(b + row0 * 128 + ((c ^ ((row0 >> 1) & 7)) << 4));
                k1 = *(const bf16x8*)(b + row1 * 128 + ((c ^ ((row1 >> 1) & 7)) << 4));
            } else {
                const int row0 = kap, row1 = 32 + kap, c = 2 * (ks - 4) + h;
                k0 = *(const bf16x8*)(b + 16384 + row0 * 64 + ((c ^ ((row0 >> 2) & 3)) << 4));
                k1 = *(const bf16x8*)(b + 16384 + row1 * 64 + ((c ^ ((row1 >> 2) & 3)) << 4));
            }
            s0 = MFMA32(k0, qf[ks], s0);
            s1 = MFMA32(k1, qf[ks], s1);
        }
    };
    auto pv = [&](int st, const u32x4 (&pw)[4]) {
        const unsigned char* b = lds + st * 20480;
#pragma unroll
        for (int s4 = 0; s4 < 4; ++s4) {
            const bf16x8 pf = __builtin_bit_cast(bf16x8, pw[s4]);
            const int c = 2 * s4 + h;
            const bf16x8 v0 = *(const bf16x8*)(b + 8192 + r * 128 + ((c ^ ((r >> 1) & 7)) << 4));
            const bf16x8 v1 = *(const bf16x8*)(b + 8192 + (32 + r) * 128 + ((c ^ (((32 + r) >> 1) & 7)) << 4));
            o0 = MFMA32(v0, pf, o0);
            o1 = MFMA32(v1, pf, o1);
        }
    };
    issue(-1, 0); issue(0, 1); issue(1, 2);
    if (MLA) WAIT_VM(10); else WAIT_VM(8);
    RAW_BARRIER();
    f32x16 c0, c1;
    qk(0, c0, c1);
    if (MLA) WAIT_VM(5); else WAIT_VM(4);
    RAW_BARRIER();
    u32x4 pw[4];
#pragma unroll
    for (int s4 = 0; s4 < 4; ++s4) pw[s4] = (u32x4){0u, 0u, 0u, 0u};
    int st = 1;
#pragma unroll 1
    for (int i = 0; i < ntl; ++i) {
        if (i + 2 <= ntl) issue(i + 2, st == 0 ? 2 : st - 1);
        if (!MLA) {
            if (i >= a.n1) {
                const int tk0 = tile_j0(i) - LC + 8 * h;
#pragma unroll
                for (int e = 0; e < 16; ++e) {
                    const int tk = tk0 + 16 * (e >> 3) + (e & 7);
                    int d0 = a.tq - tk; d0 = d0 < 0 ? -d0 : d0; int d1 = a.tq - (tk + 32); d1 = d1 < 0 ? -d1 : d1;
                    if (d0 > 128) c0[e] = -1e30f;
                    if (d1 > 128) c1[e] = -1e30f;
                }
            }
        }
        constexpr int NT = 2 * NKS + 8, NMAX = MLA ? 4 : 2, NE = NT - NMAX;
        const unsigned char* sb_ = lds + st * 20480;
        auto frag = [&](int t) -> bf16x8 {
            if (t < 2 * NKS) { const int ks = t >> 1, row = (t & 1) * 32 + kap;
                if (ks < 4) { const int c = 2 * ks + h; return *(const bf16x8*)(sb_ + row * 128 + ((c ^ ((row >> 1) & 7)) << 4)); }
                else { const int c = 2 * (ks - 4) + h; return *(const bf16x8*)(sb_ + 16384 + row * 64 + ((c ^ ((row >> 2) & 3)) << 4)); } }
            else { const int u = t - 2 * NKS, s4 = u >> 1, row = (u & 1) * 32 + r, c = 2 * s4 + h; return *(const bf16x8*)(sb_ + 8192 + row * 128 + ((c ^ ((row >> 1) & 7)) << 4)); }
        };
        f32x16 n0, n1;
#pragma unroll
        for (int e = 0; e < 16; ++e) { n0[e] = 0.f; n1[e] = 0.f; }
        bf16x8 F[NT];
        F[0] = frag(0); F[1] = frag(1); F[2] = frag(2);
        float mx = c0[0], ps = 0.f, mn = 0.f, alpha = 0.f;
        SETPRIO(1);
        SCHED_FENCE();
#pragma unroll
        for (int t = 0; t < NT; ++t) {
            if (t < 2 * NKS) { const int ks = t >> 1; if (t & 1) n1 = MFMA32(F[t], qf[ks], n1); else n0 = MFMA32(F[t], qf[ks], n0); }
            else { const int u = t - 2 * NKS; const bf16x8 pf = __builtin_bit_cast(bf16x8, pw[u >> 1]); if (u & 1) o1 = MFMA32(F[t], pf, o1); else o0 = MFMA32(F[t], pf, o0); }
            if (t + 3 < NT) F[t + 3] = frag(t + 3);
            if (t < NMAX) {
                constexpr int PER = 32 / NMAX;
#pragma unroll
                for (int k = 0; k < PER; ++k) { const int e = t * PER + k; mx = fmaxf(mx, e < 16 ? c0[e] : c1[e - 16]); }
                if (t == NMAX - 1) { mx = xhalf_max2(mx, m); mn = fmaxf(m, mx); alpha = fast_exp2(m - mn); m = mn; }
                PIN1(mx);
            } else {
                const int s_ = t - NMAX;
                float mnk = mn; PIN1(mnk);
#pragma unroll
                for (int e = s_ * 16 / NE; e < (s_ + 1) * 16 / NE; ++e) { float x0 = fast_exp2(c0[e] - mnk), x1 = fast_exp2(c1[e] - mnk); PIN2(x0, x1); c0[e] = x0; c1[e] = x1; ps += x0 + x1; }
            }
            SCHED_FENCE();
        }
        SETPRIO(0);
        l = l * alpha + ps;
#pragma unroll
        for (int s4 = 0; s4 < 4; ++s4) {
            const int e0 = 8 * (s4 & 1);
            if (s4 < 2) pw[s4] = (u32x4){pack2(c0[e0], c0[e0 + 1]), pack2(c0[e0 + 2], c0[e0 + 3]), pack2(c0[e0 + 4], c0[e0 + 5]), pack2(c0[e0 + 6], c0[e0 + 7])};
            else pw[s4] = (u32x4){pack2(c1[e0], c1[e0 + 1]), pack2(c1[e0 + 2], c1[e0 + 3]), pack2(c1[e0 + 4], c1[e0 + 5]), pack2(c1[e0 + 6], c1[e0 + 7])};
        }
#pragma unroll
        for (int e = 0; e < 16; ++e) { o0[e] *= alpha; o1[e] *= alpha; }
        c0 = n0; c1 = n1;
        if (i + 2 <= ntl) { if (MLA) WAIT_VM(5); else WAIT_VM(4); } else WAIT_VM(0);
        RAW_BARRIER();
        st = st == 2 ? 0 : st + 1;
    }
    pv(st, pw);
    RAW_BARRIER();
    float lt = l + __shfl_xor(l, 32);
    if (!MLA) lt += fast_exp2(a.sink2 - m);
    const float inv = 1.0f / lt;
    float ssq = 0.f;
#pragma unroll
    for (int e = 0; e < 16; ++e) { o0[e] *= inv; o1[e] *= inv; ssq += o0[e] * o0[e] + o1[e] * o1[e]; }
    ssq += __shfl_xor(ssq, 32);
#pragma unroll
    for (int gp = 0; gp < 2; ++gp) {
        const int g = 2 * gp;
        *(u32x4*)(a.o + 8 * (g + h)) = widen_pair32((u32x2){pack2(o0[4 * g], o0[4 * g + 1]), pack2(o0[4 * g + 2], o0[4 * g + 3])}, (u32x2){pack2(o0[4 * g + 4], o0[4 * g + 5]), pack2(o0[4 * g + 6], o0[4 * g + 7])});
        *(u32x4*)(a.o + 32 + 8 * (g + h)) = widen_pair32((u32x2){pack2(o1[4 * g], o1[4 * g + 1]), pack2(o1[4 * g + 2], o1[4 * g + 3])}, (u32x2){pack2(o1[4 * g + 4], o1[4 * g + 5]), pack2(o1[4 * g + 6], o1[4 * g + 7])});
    }
    if (h == 0) *a.ss = ssq;
}

__device__ __forceinline__ int unit_of(int round, int bid, int nb) {
    return (nb % 8 == 0) ? round * nb + (bid % 8) * (nb / 8) + bid / 8 : round * nb + bid;
}
#define FOR_UNITS(u, total) for (int _rd = 0, u = unit_of(0, bid, nb); (_rd * nb) < (total); ++_rd, u = unit_of(_rd, bid, nb)) if (u < (total))
#define FOR_UNITS_ROT(u, total, rot) for (int _rd = 0, _b2 = (bid + (rot)) % nb, u = unit_of(0, _b2, nb); (_rd * nb) < (total); ++_rd, u = unit_of(_rd, _b2, nb)) if (u < (total))

__device__ __forceinline__ void mod_unit(const Params& p, int u, unsigned char* lds) {
    constexpr int NCHK = 6 * D / 64;
    const int l = u / NCHK, ck = u % NCHK, tid = tidx(), lane = tid & 63, w = tid >> 6;
    float* sl = (float*)lds;
    for (int i = tid; i < 17 * D; i += NTHREADS) { const int r = i / D, k = i % D; const float v = r < NB ? p.in[1][r * D + k] : p.in[3][k]; sl[i] = v / (1.0f + expf(-v)); }
    __syncthreads();
    float acc[17];
#pragma unroll
    for (int r = 0; r < 17; ++r) acc[r] = 0.f;
    const float* W = p.in[4] + (size_t)l * D * 6 * D + ck * 64 + lane;
    for (int k0 = w * (D / 4); k0 < (w + 1) * (D / 4); k0 += 16) {
        float wv[16];
#pragma unroll
        for (int j = 0; j < 16; ++j) wv[j] = W[(size_t)(k0 + j) * 6 * D];
#pragma unroll
        for (int j = 0; j < 16; ++j)
#pragma unroll
            for (int r = 0; r < 17; ++r) acc[r] += sl[r * D + k0 + j] * wv[j]; }
    __syncthreads();
    float* red = (float*)lds;
#pragma unroll
    for (int r = 0; r < 17; ++r) red[(w * 17 + r) * 64 + lane] = acc[r];
    __syncthreads();
    for (int i = tid; i < 17 * 64; i += NTHREADS) { const int r = i / 64, c = i % 64;
        const float s = ((red[(0 * 17 + r) * 64 + c] + red[(1 * 17 + r) * 64 + c]) + red[(2 * 17 + r) * 64 + c]) + red[(3 * 17 + r) * 64 + c];
        ((float*)(p.ws + WS_MOD))[(size_t)(l * 17 + r) * 6 * D + ck * 64 + c] = s + p.in[5][(size_t)l * 6 * D + ck * 64 + c]; }
    __syncthreads();
}
__device__ __forceinline__ void tr_tile(const float* src, int sld, bf16_t* dst, int dld, int k0, int n0, int nmax, const float* gk, float scale, unsigned char* lds) {
    float* t = (float*)lds;
    const int tid = tidx();
#pragma unroll
    for (int i = 0; i < 16; ++i) { const int k = i * 4 + (tid >> 6), n = tid & 63;
        const bool ok = n0 + n < nmax; const int nc = ok ? n0 + n : nmax - 1;
        const float v = src[(size_t)(k0 + k) * sld + nc] * (gk ? gk[k0 + k] : 1.0f) * scale;
        t[k * 65 + n] = ok ? v : 0.f; }
    __syncthreads();
#pragma unroll 4
    for (int i = 0; i < 8; ++i) { const int n = i * 8 + (tid >> 5), k = 2 * (tid & 31);
        if (n0 + n < nmax) *(unsigned*)(dst + (size_t)(n0 + n) * dld + k0 + k) = pack2(t[k * 65 + n], t[(k + 1) * 65 + n]); }
    __syncthreads();
}
constexpr int TR_IN = (D / 64) * 31, TR_UQ = 24, TR_UKV = 16, TR_OUT = 16 * (D / 64), TR_LRU = 128, TR_RT = 5 * (D / 64), TR_EX = 32 * 3 * 4 * (D / 64);
constexpr int TR_PER_LAYER = TR_IN + TR_UQ + TR_UKV + TR_OUT + TR_LRU + TR_RT + TR_EX;
__device__ __forceinline__ void tr_unit(const Params& p, int u, unsigned char* lds) {
    const int l = u / TR_PER_LAYER; int t = u % TR_PER_LAYER;
    constexpr int KD = D / 64;
    if (t < TR_IN) { const int kt = t / 31, nt = t % 31; tr_tile(p.in[8] + (size_t)l * D * INC, INC, (bf16_t*)(p.ws + WS_WIN) + (size_t)l * 2048 * D, D, kt * 64, nt * 64, INC, nullptr, 1.f, lds); return; }
    t -= TR_IN;
    if (t < TR_UQ) { const int kt = t / 6, nt = t % 6; tr_tile(p.in[10] + (size_t)l * 256 * 384, 384, (bf16_t*)(p.ws + WS_WUQ) + (size_t)l * 384 * 256, 256, kt * 64, nt * 64, 384, p.in[9] + l * 256, 0.10206207261596577f * LOG2E, lds); return; }
    t -= TR_UQ;
    if (t < TR_UKV) { const int kt = t / 8, nt = t % 8; tr_tile(p.in[12] + (size_t)l * 128 * 512, 512, (bf16_t*)(p.ws + WS_WUKV) + (size_t)l * 512 * 128, 128, kt * 64, nt * 64, 512, p.in[11] + l * 128, 1.f, lds); return; }
    t -= TR_UKV;
    if (t < TR_OUT) { const int kt = t / KD, nt = t % KD; tr_tile(p.in[22] + (size_t)l * MIXW * D, D, (bf16_t*)(p.ws + WS_WOUT) + (size_t)l * D * MIXW, MIXW, kt * 64, nt * 64, D, p.in[21] + l * MIXW, 1.f, lds); return; }
    t -= TR_OUT;
    if (t < TR_LRU) { const int tap = t >> 5, dir = (t >> 4) & 1, gate = (t >> 3) & 1, n = t & 7;
        tr_tile((gate ? p.in[18] : p.in[16]) + ((size_t)(l * 2 + dir) * 8 + n) * 4096, 64, (bf16_t*)(p.ws + WS_WLRU) + (((((size_t)(l * 8 + n) * 2 + dir) * 4 + tap) * 2 + gate) * 64) * 64, 64, 0, 0, 64,
                p.in[14] + (size_t)l * 4 * 512 + tap * 512 + n * 64, -LOG2E, lds); return; }
    t -= TR_LRU;
    if (t < TR_RT) { const int which = t / KD, kt = t % KD; bf16_t* dst = (bf16_t*)(p.ws + WS_WRT) + (size_t)l * 64 * D;
        if (which == 0) tr_tile(p.in[23] + (size_t)l * D * 4, 4, dst, D, kt * 64, 0, 4, nullptr, 1.f, lds);
        else { const int g = which - 1; tr_tile(p.in[25] + ((size_t)l * 4 + g) * D * 8, 8, dst + (size_t)(4 + 8 * g) * D, D, kt * 64, 0, 8, nullptr, 1.f, lds); }
        return; }
    t -= TR_RT;
    { const int e = t / (12 * KD); int r = t % (12 * KD); const int which = r / (4 * KD); r %= 4 * KD;
        if (which < 2) { const int kt = r / 4, nt = r % 4;
            tr_tile(p.in[27 + which] + ((size_t)l * 32 + e) * D * DE, DE, (bf16_t*)(p.ws + (which ? WS_WEU : WS_WEG)) + ((size_t)l * 32 + e) * DE * D, D, kt * 64, nt * 64, DE, nullptr, 1.f, lds); }
        else { const int kt = r / KD, nt = r % KD;
            tr_tile(p.in[29] + ((size_t)l * 32 + e) * DE * D, D, (bf16_t*)(p.ws + WS_WED) + ((size_t)l * 32 + e) * D * DE, DE, kt * 64, nt * 64, D, nullptr, 1.f, lds); } }
}
__device__ __forceinline__ void rope_unit(const Params& p) {
    const int f = tidx(); if (f >= 24) return;
    const double fr16[16] = {1.0, 0.5623413251903491, 0.31622776601683794, 0.1778279410038923, 0.1, 0.05623413251903491, 0.031622776601683791, 0.01778279410038923,
                             0.01, 0.005623413251903491, 0.0031622776601683794, 0.001778279410038923, 0.001, 0.0005623413251903491, 0.00031622776601683794, 0.0001778279410038923};
    const double w = f < 16 ? fr16[f] : fr16[2 * (f - 16)];
    double c1 = 1.0, s1 = 0.0, term = 1.0;
    for (int n = 1; n <= 24; ++n) { term *= w / n; if (n & 1) s1 += ((n >> 1) & 1) ? -term : term; else c1 += ((n >> 1) & 1) ? -term : term; }
    float* T = (float*)(p.ws + WS_ROPE);
    double c = 1.0, s = 0.0;
    for (int pos = 0; pos < 64; ++pos) {
        if (f < 16) { T[pos * 16 + f] = (float)c; T[1024 + pos * 16 + f] = (float)s; }
        else { T[2048 + pos * 8 + (f - 16)] = (float)c; T[2560 + pos * 8 + (f - 16)] = (float)s; }
        const double cn = c * c1 - s * s1, sn = s * c1 + c * s1; c = cn; s = sn;
    }
}
constexpr int N_MOD_UNITS = DEPTH * 6 * D / 64, N_TR_UNITS = DEPTH * TR_PER_LAYER;
__device__ __forceinline__ void phase_prologue(const Params& p, int bid, int nb, unsigned char* lds) {
    for (int u = bid; u < N_MOD_UNITS; u += nb) mod_unit(p, u, lds);
    for (int u = nb - 1 - bid; u < N_TR_UNITS; u += nb) tr_unit(p, u, lds);
    if (bid == nb / 2) rope_unit(p);
}

template <int MODE, class XF, class YF, class MF>
__device__ __forceinline__ void norm_run(const Params& p, int layer, const float* g, int which_sc, int which_sh, int r0, int r1, int lane, const XF& xf, const YF& yf, const MF& mf) {
    constexpr int NV = D / 256;
    f32x4 gm[NV], sh[NV]; int cur = -2;
    for (int rb = r0; rb < r1; rb += 4) {
        f32x4 v[4][NV];
#pragma unroll
        for (int q = 0; q < 4; ++q) { const int row = rb + q < r1 ? rb + q : r1 - 1;
#pragma unroll
            for (int i = 0; i < NV; ++i) v[q][i] = xf(row, (i * 64 + lane) * 4); }
        float ss[4];
#pragma unroll
        for (int q = 0; q < 4; ++q) { float a = 0.f;
#pragma unroll
            for (int i = 0; i < NV; ++i) a += v[q][i][0] * v[q][i][0] + v[q][i][1] * v[q][i][1] + v[q][i][2] * v[q][i][2] + v[q][i][3] * v[q][i][3];
            ss[q] = a; }
#pragma unroll
        for (int o = 32; o >= 1; o >>= 1) {
#pragma unroll
            for (int q = 0; q < 4; ++q) ss[q] += __shfl_xor(ss[q], o); }
#pragma unroll
        for (int q = 0; q < 4; ++q) { const int row = rb + q; if (row < r1) {
            const int mi = mf(row);
            if (mi != cur) { cur = mi;
#pragma unroll
                for (int i = 0; i < NV; ++i) { const int k = (i * 64 + lane) * 4; const f32x4 gv = *(const f32x4*)(g + k);
                    if (MODE == 0) { const f32x4 scv = *(const f32x4*)(mod_ptr(p, layer, mi, which_sc) + k); gm[i] = gv * (scv + 1.0f); sh[i] = *(const f32x4*)(mod_ptr(p, layer, mi, which_sh) + k); }
                    else { gm[i] = gv; sh[i] = (f32x4){0.f, 0.f, 0.f, 0.f}; } } }
            const float r = fast_rsqrt(ss[q] * (1.0f / D) + EPS);
#pragma unroll
            for (int i = 0; i < NV; ++i) { const int k = (i * 64 + lane) * 4; const f32x4 o = v[q][i] * r * gm[i] + sh[i];
                if (MODE == 0) *(u32x2*)((bf16_t*)yf(row) + k) = (u32x2){pack2(o[0], o[1]), pack2(o[2], o[3])};
                else *(f32x4*)((float*)yf(row) + k) = o; } } }
    }
}
__device__ __forceinline__ void phase_norm1(const Params& p, int layer, int bid, int nb) {
    const int lane = tidx() & 63, gw = bid * 4 + (tidx() >> 6), nw = nb * 4;
    bf16_t* H = (bf16_t*)(p.ws + WS_H);
    const int per = (R + nw - 1) / nw, r0 = gw * per, r1 = r0 + per < R ? r0 + per : R;
    norm_run<0>(p, layer, p.in[6] + layer * D, 1, 0, r0, r1, lane, [&](int row, int k) { return xload4(p, layer, row, k); }, [&](int row) { return (void*)(H + (size_t)row * D); }, [&](int row) { return mod_index(row); });
}
__device__ __forceinline__ void phase_final(const Params& p, int bid, int nb) {
    const int lane = tidx() & 63, gw = bid * 4 + (tidx() >> 6), nw = nb * 4;
    const int per = (NB * S + nw - 1) / nw, r0 = gw * per, r1 = r0 + per < NB * S ? r0 + per : NB * S;
    norm_run<1>(p, 0, p.in[30], 0, 0, r0, r1, lane, [&](int i, int k) { return xload4s(p, (i / S) * J + LC + (i % S), k); }, [&](int i) { return (void*)(p.out + (size_t)i * D); }, [&](int) { return 0; });
}

__device__ __forceinline__ void phase_inproj(const Params& p, int layer, int bid, int nb, unsigned char* lds) {
    const bf16_t* H = (const bf16_t*)(p.ws + WS_H); const bf16_t* W = (const bf16_t*)(p.ws + WS_WIN) + (size_t)layer * 2048 * D;
    bf16_t* Z = (bf16_t*)(p.ws + WS_Z); float* ZSS = (float*)(p.ws + WS_ZSS);
    constexpr int NT = 8, total = (R / 128) * NT;
    FOR_UNITS(u, total) {
        const int mt = u / NT, nt = u % NT;
        const bf16_t* zrow = (const bf16_t*)(p.ws + WS_ZROW);
        auto ap = [&](int r) -> const bf16_t* { return H + (size_t)(mt * 128 + r) * D; };
        auto bp = [&](int n) -> const bf16_t* { const int c = nt * 256 + n; return c < INC ? W + (size_t)c * D : zrow; };
        auto epi = [&](const f32x4 (&acc)[4][8], int wr, int wc, int fr, int fq) {
#pragma unroll
            for (int mi = 0; mi < 4; ++mi) { const int row = mt * 128 + wr * 64 + mi * 16 + fr; float ss = 0.f;
#pragma unroll
                for (int np = 0; np < 4; ++np) { const f32x4 va = acc[mi][2 * np], vb = acc[mi][2 * np + 1];
                    ss += (va[0] * va[0] + va[1] * va[1] + va[2] * va[2] + va[3] * va[3]) + (vb[0] * vb[0] + vb[1] * vb[1] + vb[2] * vb[2] + vb[3] * vb[3]);
                    const u32x4 o = widen_pair((u32x2){pack2(va[0], va[1]), pack2(va[2], va[3])}, (u32x2){pack2(vb[0], vb[1]), pack2(vb[2], vb[3])});
                    const int col = nt * 256 + wc * 128 + (2 * np + (fq & 1)) * 16 + (fq & 2) * 4;
                    if (col < INC) *(u32x4*)(Z + (size_t)row * INC + col) = o; }
                if (nt == 0 || (nt == 1 && wc == 0)) { ss += __shfl_xor(ss, 16); ss += __shfl_xor(ss, 32); if (fq == 0) ZSS[(size_t)row * 8 + nt * 2 + wc] = ss; } }
        };
        gemm_tile2<false>(ap, bp, bp, D, D / 32, lds, NoGS(), epi);
    }
}

__device__ __forceinline__ void prep_q_unit(const Params& p, int layer, int u, unsigned char* lds) {
    const int mt = u / 3, nt = u % 3;
    const bf16_t* Z = (const bf16_t*)(p.ws + WS_Z); const float* ZSS = (const float*)(p.ws + WS_ZSS);
    const bf16_t* W = (const bf16_t*)(p.ws + WS_WUQ) + (size_t)layer * 384 * 256; bf16_t* Q = (bf16_t*)(p.ws + WS_Q);
    const float* T8 = (const float*)(p.ws + WS_ROPE) + 2048;
    auto ap = [&](int r) -> const bf16_t* { return Z + (size_t)(mt * 128 + r) * INC + C_CQ; };
    auto bp = [&](int n) -> const bf16_t* { return W + (size_t)(nt * 128 + n) * 256; };
    auto epi = [&](const f32x4 (&acc)[4][4], int wr, int wc, int fr, int fq) {
#pragma unroll
        for (int mi = 0; mi < 4; ++mi) { const int row = mt * 128 + wr * 64 + mi * 16 + fr, b = row / J, j = row - b * J;
            const float* zs = ZSS + (size_t)row * 8; const float rs = fast_rsqrt((zs[0] + zs[1]) * (1.0f / 256.0f) + EPS);
            const bool lat = j >= LC; const int t = j - LC, prow = t / GW, pcol = t % GW;
            u32x2 pk[4];
#pragma unroll
            for (int ni = 0; ni < 4; ++ni) { const int c16 = nt * 8 + wc * 4 + ni, g16 = c16 % 6; f32x4 v = acc[mi][ni] * rs;
                if (g16 >= 4) {
                    f32x4 o;
#pragma unroll
                    for (int e = 0; e < 4; ++e) o[e] = __shfl_xor(v[e], 32);
                    if (lat) { const int pos = g16 == 4 ? prow : pcol; const float* cs = T8 + pos * 8 + (fq & 1) * 4; const float* sn = cs + 512;
#pragma unroll
                        for (int e = 0; e < 4; ++e) v[e] = fq < 2 ? v[e] * cs[e] - o[e] * sn[e] : v[e] * cs[e] + o[e] * sn[e]; } }
                pk[ni] = (u32x2){pack2(v[0], v[1]), pack2(v[2], v[3])}; }
#pragma unroll
            for (int np = 0; np < 2; ++np) { const u32x4 ow = widen_pair(pk[2 * np], pk[2 * np + 1]);
                const int c16 = nt * 8 + wc * 4 + 2 * np + (fq & 1), g16 = c16 % 6, head = c16 / 6;
                *(u32x4*)(Q + ((size_t)(b * 4 + head) * J + j) * 96 + g16 * 16 + (fq & 2) * 4) = ow; } }
    };
    gemm_tile<4, false>(ap, bp, bp, 256, 4, lds, NoGS(), epi);
}
__device__ __forceinline__ void prep_kv_unit(const Params& p, int layer, int u, unsigned char* lds) {
    const int mt = u / 4, hd = u % 4;
    const bf16_t* Z = (const bf16_t*)(p.ws + WS_Z); const float* ZSS = (const float*)(p.ws + WS_ZSS);
    const bf16_t* W = (const bf16_t*)(p.ws + WS_WUKV) + (size_t)layer * 512 * 128; bf16_t* KN = (bf16_t*)(p.ws + WS_KN); bf16_t* VT = (bf16_t*)(p.ws + WS_VT);
    auto ap = [&](int r) -> const bf16_t* { return Z + (size_t)(mt * 128 + r) * INC + C_CKV; };
    auto bp = [&](int n) -> const bf16_t* { return W + (size_t)(hd * 128 + n) * 128; };
    auto epi = [&](const f32x4 (&acc)[4][4], int wr, int wc, int fr, int fq) {
#pragma unroll
        for (int mi = 0; mi < 4; ++mi) { const int row = mt * 128 + wr * 64 + mi * 16 + fr, b = row / J, j = row - b * J;
            const float* zs = ZSS + (size_t)row * 8; const float rs = fast_rsqrt(zs[2] * (1.0f / 128.0f) + EPS);
            if (wc == 0) {
#pragma unroll
                for (int np = 0; np < 2; ++np) { const f32x4 va = acc[mi][2 * np] * rs, vb = acc[mi][2 * np + 1] * rs;
                    const u32x4 ow = widen_pair((u32x2){pack2(va[0], va[1]), pack2(va[2], va[3])}, (u32x2){pack2(vb[0], vb[1]), pack2(vb[2], vb[3])});
                    *(u32x4*)(KN + ((size_t)(b * 4 + hd) * J + j) * 64 + (2 * np + (fq & 1)) * 16 + (fq & 2) * 4) = ow; }
            } else {
#pragma unroll
                for (int ni = 0; ni < 4; ++ni) { const f32x4 v = acc[mi][ni] * rs; const int c = ni * 16 + fq * 4;
#pragma unroll
                    for (int e = 0; e < 4; ++e) *(bf16_t*)(lds + (c + e) * 272 + (wr * 64 + mi * 16 + fr) * 2) = f2bf(v[e]); } } }
        __syncthreads();
        { const int t_ = tidx(), l_ = t_ & 63, w_ = t_ >> 6, b = (mt * 128) / J, j0 = mt * 128 - b * J;
#pragma unroll
          for (int i = 0; i < 4; ++i) { const int d = w_ * 16 + i * 4 + (l_ >> 4), ch = l_ & 15;
              *(u32x4*)(VT + ((size_t)(b * 4 + hd) * 64 + d) * J + j0 + ch * 8) = *(const u32x4*)(lds + d * 272 + ch * 16); } }
        __syncthreads();
    };
    gemm_tile<4, false>(ap, bp, bp, 128, 2, lds, NoGS(), epi);
}
__device__ __forceinline__ void rope8(u32x4& A, u32x4& B, const float* cs, const float* sn, bool rot, float scale) {
#pragma unroll
    for (int i = 0; i < 4; ++i) {
        const float a0 = bf2f((bf16_t)(A[i] & 0xffff)), a1 = bf2f((bf16_t)(A[i] >> 16)), b0 = bf2f((bf16_t)(B[i] & 0xffff)), b1 = bf2f((bf16_t)(B[i] >> 16));
        float c0 = 1.f, s0 = 0.f, c1 = 1.f, s1 = 0.f; if (rot) { c0 = cs[2 * i]; s0 = sn[2 * i]; c1 = cs[2 * i + 1]; s1 = sn[2 * i + 1]; }
        A[i] = pack2((a0 * c0 - b0 * s0) * scale, (a1 * c1 - b1 * s1) * scale);
        B[i] = pack2((b0 * c0 + a0 * s0) * scale, (b1 * c1 + a1 * s1) * scale); }
}
__device__ __forceinline__ void prep_rope_unit(const Params& p, int u, unsigned char* lds) {
    const bf16_t* Z = (const bf16_t*)(p.ws + WS_Z);
    bf16_t* KR = (bf16_t*)(p.ws + WS_KR); bf16_t* SQ = (bf16_t*)(p.ws + WS_SQ); bf16_t* SK = (bf16_t*)(p.ws + WS_SK); bf16_t* SVT = (bf16_t*)(p.ws + WS_SVT);
    const float* T16 = (const float*)(p.ws + WS_ROPE); const float* T8 = T16 + 2048;
    const int tid = tidx(), row0 = u * 64;
    for (int job = tid; job < 64 * 26; job += NTHREADS) {
        const int rl = job / 26, q = job % 26, row = row0 + rl, b = row / J, j = row - b * J; const bool lat = j >= LC; const int t = j - LC, prow = t / GW, pcol = t % GW;
        const bf16_t* z = Z + (size_t)row * INC;
        if (q < 2) {
            u32x4 A = *(const u32x4*)(z + C_KR + q * 16), B = *(const u32x4*)(z + C_KR + q * 16 + 8);
            const int pos = q == 0 ? prow : pcol; rope8(A, B, T8 + pos * 8, T8 + 512 + pos * 8, lat, 1.0f);
            bf16_t* d = KR + ((size_t)b * J + j) * 32 + q * 16; *(u32x4*)d = A; *(u32x4*)(d + 8) = B;
        } else {
            const int qq = q - 2, isk = qq >= 16, hq = isk ? (qq - 16) >> 2 : qq >> 2, part = qq & 3, axis = part >> 1, half8 = part & 1;
            const int cbase = (isk ? C_SK : C_SQ) + hq * 64 + axis * 32 + half8 * 8;
            u32x4 A = *(const u32x4*)(z + cbase), B = *(const u32x4*)(z + cbase + 16);
            const int pos = axis == 0 ? prow : pcol; rope8(A, B, T16 + pos * 16 + half8 * 8, T16 + 1024 + pos * 16 + half8 * 8, lat, isk ? 1.0f : 0.125f * LOG2E);
            bf16_t* d = (isk ? SK + ((size_t)(b * 2 + hq) * J + j) * 64 : SQ + ((size_t)(b * 4 + hq) * J + j) * 64) + axis * 32 + half8 * 8;
            *(u32x4*)d = A; *(u32x4*)(d + 16) = B;
        }
    }
    bf16_t* t = (bf16_t*)lds;
    for (int c = tid; c < 64 * 16; c += NTHREADS) { const int rl = c >> 4, ch = c & 15; *(u32x4*)(t + rl * 136 + ch * 8) = *(const u32x4*)(Z + (size_t)(row0 + rl) * INC + C_SV + ch * 8); }
    __syncthreads();
    { const int b = row0 / J, j0 = row0 - b * J, w_ = tid >> 6, dl = (tid >> 3) & 7, ch = tid & 7;
#pragma unroll
        for (int i = 0; i < 4; ++i) { const int d = w_ * 32 + i * 8 + dl; u32x4 o;
#pragma unroll
            for (int e = 0; e < 4; ++e) o[e] = (unsigned)t[(ch * 8 + 2 * e) * 136 + d] | ((unsigned)t[(ch * 8 + 2 * e + 1) * 136 + d] << 16);
            *(u32x4*)(SVT + ((size_t)(b * 2 + (d >> 6)) * 64 + (d & 63)) * J + j0 + ch * 8) = o; } }
    __syncthreads();
}

struct AB { float a, b; };
__device__ __forceinline__ AB comb(AB L, AB Rr) { return AB{Rr.a * L.a, Rr.a * L.b + Rr.b}; }
#ifdef EMU
#define WAVE_SYNC() emu_wave_sync()
#define BLOCK_FENCE() do {} while (0)
#define SPIN_WAIT(cond) while (!(cond)) emu_yield()
#define LDSAS
#define LDS_ORDER() emu_wave_sync()
#else
#define SPIN_WAIT(cond) while (!(cond)) __builtin_amdgcn_s_sleep(1)
#define LDSAS __attribute__((address_space(3)))
#define LDS_ORDER() asm volatile("s_waitcnt lgkmcnt(0)" ::: "memory")
#define WAVE_SYNC() asm volatile("" ::: "memory")
#define BLOCK_FENCE() __builtin_amdgcn_fence(__ATOMIC_SEQ_CST, "workgroup")
#endif
constexpr int N_LRUS = NB * 32, LRU_IT = J / 256, LRU_ITC = LC / 256;
template <int DIR>
__device__ __forceinline__ void lru_seq_pass(const Params& p, int layer, bool last, int u, unsigned char* lds) {
    const int n = u & 7, q = (u >> 3) & 3, b = u >> 5;
    const int tid = tidx(), lane = tid & 63, w = tid >> 6, fr = lane & 15, fq = lane >> 4;
    const bf16_t* Z = (const bf16_t*)(p.ws + WS_Z);
    unsigned char* st = lds + w * 9216;
    unsigned char* wl = lds + 36864;
    volatile LDSAS int* flg = (volatile LDSAS int*)(lds + 57344);
    volatile LDSAS float* cout_ = (volatile LDSAS float*)(lds + 57344 + 64);
    const int cg = n * 64 + 16 * q + fr;
    bf16x8 wfr[4];
    { const bf16_t* WL = (const bf16_t*)(p.ws + WS_WLRU) + ((((size_t)(layer * 8 + n) * 2 + DIR) * 4 + w) * 2) * 4096;
#pragma unroll
      for (int idx = 0; idx < 4; ++idx) { const int ri = idx >> 1, ks = idx & 1; wfr[idx] = *(const bf16x8*)(WL + (size_t)ri * 4096 + (16 * q + fr) * 64 + ks * 32 + fq * 8); } }
    const float cwv = p.in[14][(size_t)layer * 4 * 512 + w * 512 + cg];
    float br, bi;
    {
        const float* wa = p.in[16] + ((size_t)(layer * 2 + DIR) * 8 + n) * 4096 + 16 * q + fr; const float* wx = p.in[18] + ((size_t)(layer * 2 + DIR) * 8 + n) * 4096 + 16 * q + fr;
        const float* cb = p.in[15] + layer * 512 + n * 64;
        float sr = 0.f, si = 0.f;
        float cv[16], av_[16], xv_[16];
#pragma unroll
        for (int k = 0; k < 16; ++k) { cv[k] = cb[fq * 16 + k]; av_[k] = wa[(fq * 16 + k) * 64]; xv_[k] = wx[(fq * 16 + k) * 64]; }
#pragma unroll
        for (int k = 0; k < 16; ++k) { sr += cv[k] * av_[k]; si += cv[k] * xv_[k]; }
        sr += __shfl_xor(sr, 16); sr += __shfl_xor(sr, 32); si += __shfl_xor(si, 16); si += __shfl_xor(si, 32);
        br = -LOG2E * (sr + p.in[17][(layer * 2 + DIR) * 512 + cg]); bi = -LOG2E * (si + p.in[19][(layer * 2 + DIR) * 512 + cg]);
    }
    const float cbo = p.in[15][layer * 512 + cg], lam = p.in[20][(layer * 2 + DIR) * 512 + cg];
    const float xe = expf(-lam); const float sp = xe * (1.0f - xe * (0.5f - xe * (1.0f / 3.0f - xe * 0.25f)));
    const float spl = -8.0f * LOG2E * sp;
    bf16_t* HFu = (bf16_t*)(p.ws + WS_HF) + (size_t)u * 16 * J + (size_t)fr * J;
    bf16_t* M = (bf16_t*)(p.ws + WS_H); float* SSo = (float*)(p.ws + WS_SS);
    const int rr = lane >> 3, ch8 = lane & 7, qh = q >> 1;
    const bf16_t* zrow_ = (const bf16_t*)(p.ws + WS_ZROW);
    auto jp_of = [&](int it) -> int { return DIR == 0 ? it * 256 : (it < LRU_ITC ? LC - 256 * (it + 1) : J - 256 * (it - LRU_ITC + 1)); };
    u32x4 zr[9];
    auto load_rows = [&](int it) {
        const int jp0 = jp_of(it), j0 = jp0 + 64 * w, seg_lo = jp0 < LC ? 0 : LC, seg_hi = jp0 < LC ? LC : J;
#pragma unroll
        for (int i = 0; i < 9; ++i) { const int s = rr + 8 * i, j = j0 - 2 + s; const bool ok = j >= seg_lo && j < seg_hi && s < 67;
            const bf16_t* src = ok ? Z + (size_t)(b * J + j) * INC + C_LX + n * 64 + ch8 * 8 : zrow_;
            zr[i] = *(const u32x4*)src; }
    };
    load_rows(0);
    {
#pragma unroll
        for (int idx = 0; idx < 4; ++idx) *(bf16x8*)(wl + (w * 5 + idx) * 1024 + lane * 16) = wfr[idx];
        const short cwb = (short)f2bf(cwv);
        const bool mine = fq == 2 * (q & 1) + (fr >> 3);
        bf16x8 dg;
#pragma unroll
        for (int e = 0; e < 8; ++e) dg[e] = (mine && e == (fr & 7)) ? cwb : (short)0;
        *(bf16x8*)(wl + (w * 5 + 4) * 1024 + lane * 16) = dg;
    }
    if (tid < 4) flg[tid] = 0;
    const int pw = DIR == 0 ? (w + 3) & 3 : (w + 1) & 3;
    const bool firstw = DIR == 0 ? w == 0 : w == 3;
    __syncthreads();
#pragma unroll 1
    for (int it = 0; it < LRU_IT; ++it) {
        const int jp0 = jp_of(it), j0 = jp0 + 64 * w; const bool outp = DIR == 1 && !(last && jp0 < LC);
        WAVE_SYNC();
#pragma unroll
        for (int i = 0; i < 9; ++i) *(u32x4*)(st + (rr + 8 * i) * 128 + ((ch8 ^ rr) << 4)) = zr[i];
        WAVE_SYNC();
        if (it + 1 < LRU_IT) load_rows(it + 1);
        f32x4 hfv[4]; u32x4 z7a, z7b;
        if (DIR == 1) {
#pragma unroll
            for (int mp = 0; mp < 2; ++mp) {
                const u32x4 hw = *(const u32x4*)(HFu + j0 + (2 * mp + (fq & 1)) * 16 + (fq & 2) * 4);
                unsigned h0 = hw[0], h1 = hw[1], h2 = hw[2], h3 = hw[3]; swap16(h0, h2); swap16(h1, h3);
                hfv[2 * mp] = (f32x4){__builtin_bit_cast(float, h0 << 16), __builtin_bit_cast(float, h0 & 0xffff0000u), __builtin_bit_cast(float, h1 << 16), __builtin_bit_cast(float, h1 & 0xffff0000u)};
                hfv[2 * mp + 1] = (f32x4){__builtin_bit_cast(float, h2 << 16), __builtin_bit_cast(float, h2 & 0xffff0000u), __builtin_bit_cast(float, h3 << 16), __builtin_bit_cast(float, h3 & 0xffff0000u)}; }
            const bf16_t* zp = Z + ((size_t)b * J + j0 + lane) * INC + C_LG + n * 64 + 16 * q;
            z7a = *(const u32x4*)zp; z7b = *(const u32x4*)(zp + 8);
        }
        f32x4 acc[4][3];
#pragma unroll
        for (int mi = 0; mi < 4; ++mi)
            { acc[mi][0] = (f32x4){br, br, br, br}; acc[mi][1] = (f32x4){bi, bi, bi, bi}; acc[mi][2] = (f32x4){cbo, cbo, cbo, cbo}; }
        SETPRIO(1);
#pragma unroll
        for (int tap = 0; tap < 4; ++tap) {
#pragma unroll
            for (int ks = 0; ks < 2; ++ks) {
                bf16x8 uf[4];
#pragma unroll
                for (int mi = 0; mi < 4; ++mi) { const int s = mi * 16 + fr + tap; uf[mi] = *(const bf16x8*)(st + s * 128 + (((ks * 4 + fq) ^ (s & 7)) << 4)); }
                const bf16x8 wr_ = *(const bf16x8*)(wl + (tap * 5 + ks) * 1024 + lane * 16), wi_ = *(const bf16x8*)(wl + (tap * 5 + 2 + ks) * 1024 + lane * 16);
#pragma unroll
                for (int mi = 0; mi < 4; ++mi) { acc[mi][0] = MFMA16(uf[mi], wr_, acc[mi][0]); acc[mi][1] = MFMA16(uf[mi], wi_, acc[mi][1]); }
                if (ks == qh) { const bf16x8 wd_ = *(const bf16x8*)(wl + (tap * 5 + 4) * 1024 + lane * 16);
#pragma unroll
                    for (int mi = 0; mi < 4; ++mi) acc[mi][2] = MFMA16(uf[mi], wd_, acc[mi][2]); }
            }
        }
        float av[4][4], bv[4][4];
#pragma unroll
        for (int mi = 0; mi < 4; ++mi)
#pragma unroll
            for (int e = 0; e < 4; ++e) {
                const float r = fast_rcp(1.0f + fast_exp2(acc[mi][0][e])), ig = fast_rcp(1.0f + fast_exp2(acc[mi][1][e]));
                const float a_ = fast_exp2(r * spl);
                av[mi][e] = a_;
                bv[mi][e] = fast_sqrt(fmaxf(1.0f - a_ * a_, 0.f)) * (ig * acc[mi][2][e]);
            }
        SETPRIO(0);
        const int ord = DIR == 0 ? fq : 3 - fq;
        AB pre[4], ttot[4], tot{1.f, 0.f};
#pragma unroll
        for (int q4 = 0; q4 < 4; ++q4) { const int mi = DIR == 0 ? q4 : 3 - q4; AB s{1.f, 0.f};
            if (DIR == 0) {
#pragma unroll
                for (int e = 0; e < 4; ++e) s = comb(s, AB{av[mi][e], bv[mi][e]}); }
            else {
#pragma unroll
                for (int e = 3; e >= 0; --e) s = comb(s, AB{av[mi][e], bv[mi][e]}); }
            { AB o{__shfl(s.a, DIR == 0 ? lane - 16 : lane + 16), __shfl(s.b, DIR == 0 ? lane - 16 : lane + 16)}; if (ord >= 1) s = comb(o, s); }
            { AB o{__shfl(s.a, DIR == 0 ? lane - 32 : lane + 32), __shfl(s.b, DIR == 0 ? lane - 32 : lane + 32)}; if (ord >= 2) s = comb(o, s); }
            pre[mi] = s;
            const AB tl{__shfl(s.a, DIR == 0 ? 48 + fr : fr), __shfl(s.b, DIR == 0 ? 48 + fr : fr)};
            ttot[mi] = tl; tot = comb(tot, tl); }
        SETPRIO(2);
        float hin = 0.f;
        { const int need = firstw ? it : it + 1;
          if (need > 0) { SPIN_WAIT(flg[pw] >= need); hin = cout_[pw * 16 + fr]; }
          const float hout = tot.a * hin + tot.b;
          if (fq == 0) cout_[w * 16 + fr] = hout;
          LDS_ORDER();
          if (lane == 0) flg[w] = it + 1; }
        SETPRIO(0);
        float hv[4][4];
#pragma unroll
        for (int q4 = 0; q4 < 4; ++q4) { const int mi = DIR == 0 ? q4 : 3 - q4;
            const float hafter = pre[mi].a * hin + pre[mi].b;
            float hh = __shfl(hafter, DIR == 0 ? lane - 16 : lane + 16); if (ord == 0) hh = hin;
            if (DIR == 0) {
#pragma unroll
                for (int e = 0; e < 4; ++e) { hh = av[mi][e] * hh + bv[mi][e]; hv[mi][e] = hh; } }
            else {
#pragma unroll
                for (int e = 3; e >= 0; --e) { hh = av[mi][e] * hh + bv[mi][e]; hv[mi][e] = hh; } }
            hin = ttot[mi].a * hin + ttot[mi].b; }
        if (DIR == 0) {
#pragma unroll
            for (int mp = 0; mp < 2; ++mp) *(u32x4*)(HFu + j0 + (2 * mp + (fq & 1)) * 16 + (fq & 2) * 4) =
                widen_pair((u32x2){pack2(hv[2 * mp][0], hv[2 * mp][1]), pack2(hv[2 * mp][2], hv[2 * mp][3])}, (u32x2){pack2(hv[2 * mp + 1][0], hv[2 * mp + 1][1]), pack2(hv[2 * mp + 1][2], hv[2 * mp + 1][3])});
        } else if (outp) {
            unsigned char* zt = lds + 58368 + w * 4096;
            *(u32x4*)(zt + lane * 32) = z7a; *(u32x4*)(zt + lane * 32 + 16) = z7b;
            WAVE_SYNC();
#pragma unroll
            for (int mi = 0; mi < 4; ++mi)
#pragma unroll
                for (int e = 0; e < 4; ++e) { const int tk = mi * 16 + fq * 4 + e;
                    const float o = (hfv[mi][e] + hv[mi][e]) * gelu_tanh(bf2f(*(const bf16_t*)(zt + tk * 32 + fr * 2)));
                    *(bf16_t*)(zt + 2048 + tk * 32 + fr * 2) = f2bf(o); }
            WAVE_SYNC();
            const u32x4 oa = *(const u32x4*)(zt + 2048 + lane * 32), ob = *(const u32x4*)(zt + 2048 + lane * 32 + 16);
            const size_t row = (size_t)b * J + j0 + lane;
            bf16_t* mp = M + row * MIXW + 512 + n * 64 + 16 * q;
            *(u32x4*)mp = oa; *(u32x4*)(mp + 8) = ob;
            float ssq = 0.f;
#pragma unroll
            for (int k = 0; k < 4; ++k) { const float a0 = __builtin_bit_cast(float, oa[k] << 16), a1 = __builtin_bit_cast(float, oa[k] & 0xffff0000u), b0 = __builtin_bit_cast(float, ob[k] << 16), b1 = __builtin_bit_cast(float, ob[k] & 0xffff0000u);
                ssq += (a0 * a0 + a1 * a1) + (b0 * b0 + b1 * b1); }
            SSo[row * SSW + 8 + n * 4 + q] = ssq;
        }
    }
}
__device__ __forceinline__ void lru_seq_unit(const Params& p, int layer, bool last, int u, unsigned char* lds) {
    lru_seq_pass<0>(p, layer, last, u, lds);
    BLOCK_FENCE();
    __syncthreads();
    lru_seq_pass<1>(p, layer, last, u, lds);
    __syncthreads();
}
constexpr int N_PQ = (R / 128) * 3, N_PKV = (R / 128) * 4, N_PR = R / 64;
__device__ __forceinline__ void phase_prep(const Params& p, int layer, bool last, int bid, int nb, unsigned char* lds) {
    { FOR_UNITS(u, N_PQ) prep_q_unit(p, layer, u, lds); }
    { FOR_UNITS_ROT(u, N_PKV, 2) prep_kv_unit(p, layer, u, lds); }
    { FOR_UNITS_ROT(u, N_PR, 4) prep_rope_unit(p, u, lds); }
    { FOR_UNITS(u, N_LRUS) lru_seq_unit(p, layer, last, u, lds); }
}

constexpr int N_MLA_LAT = NB * 4 * (S / 128), N_MLA_CTX = NB * 4 * (LC / 128), N_SWA_LAT = NB * 2 * (S / 64), N_SWA_CTX = NB * 2 * (LC / 64);
__device__ __forceinline__ void mla_unit(const Params& p, int u, bool ctx, unsigned char* lds) {
    const int nqb = ctx ? LC / 128 : S / 128, bh = u / nqb, qb = u % nqb, b = bh >> 2, hd = bh & 3;
    const int lane = tidx() & 63, w = tidx() >> 6, j = (ctx ? 0 : LC) + qb * 128 + 32 * w + (lane & 31);
    AttnArgs a;
    a.q = (const bf16_t*)(p.ws + WS_Q) + ((size_t)bh * J + j) * 96; a.kn = (const bf16_t*)(p.ws + WS_KN) + (size_t)bh * J * 64;
    a.kr = (const bf16_t*)(p.ws + WS_KR) + (size_t)b * J * 32; a.vt = (const bf16_t*)(p.ws + WS_VT) + (size_t)bh * 64 * J;
    a.n1 = 0; a.jlo = 0; a.jhi = ctx ? LC : J; a.tq = 0; a.sink2 = 0.f;
    const size_t row = (size_t)b * J + j;
    a.o = (bf16_t*)(p.ws + WS_H) + row * MIXW + hd * 64; a.ss = (float*)(p.ws + WS_SS) + row * SSW + hd;
    attn_unit<true>(a, lds);
}
__device__ __forceinline__ void swa_unit(const Params& p, int layer, int u, bool ctx, unsigned char* lds) {
    const int nqb = ctx ? LC / 64 : S / 64, bk = u / nqb, qb = u % nqb, b = bk >> 1, kvh = bk & 1;
    const int lane = tidx() & 63, w = tidx() >> 6, hd = kvh * 2 + (w & 1), t0 = qb * 64, ql = 32 * (w >> 1) + (lane & 31), j = (ctx ? 0 : LC) + t0 + ql;
    AttnArgs a;
    a.q = (const bf16_t*)(p.ws + WS_SQ) + ((size_t)(b * 4 + hd) * J + j) * 64; a.kn = (const bf16_t*)(p.ws + WS_SK) + (size_t)bk * J * 64; a.kr = nullptr;
    a.vt = (const bf16_t*)(p.ws + WS_SVT) + (size_t)bk * 64 * J; a.n1 = LC / 64;
    if (ctx) { a.jlo = 0; a.jhi = 0; } else { const int lo = t0 - 128 < 0 ? 0 : t0 - 128, hi = t0 + 192 > S ? S : t0 + 192; a.jlo = LC + lo; a.jhi = LC + hi; }
    a.tq = t0 + ql; a.sink2 = p.in[13][layer * 4 + hd] * LOG2E;
    const size_t row = (size_t)b * J + j;
    a.o = (bf16_t*)(p.ws + WS_H) + row * MIXW + 256 + hd * 64; a.ss = (float*)(p.ws + WS_SS) + row * SSW + 4 + hd;
    attn_unit<false>(a, lds);
}
__device__ __forceinline__ void phase_attn_a(const Params& p, int layer, bool last, int bid, int nb, unsigned char* lds) {
    const int total = N_MLA_LAT + (last ? 0 : N_MLA_CTX);
    FOR_UNITS(u, total) { const bool ctx = u >= N_MLA_LAT; mla_unit(p, ctx ? u - N_MLA_LAT : u, ctx, lds); }
}
__device__ __forceinline__ void phase_attn_b(const Params& p, int layer, bool last, int bid, int nb, unsigned char* lds) {
    const int total = N_SWA_LAT + (last ? 0 : N_SWA_CTX);
    { FOR_UNITS(u, total) { const bool ctx = u >= N_SWA_LAT; swa_unit(p, layer, ctx ? u - N_SWA_LAT : u, ctx, lds); } }
}

__device__ __forceinline__ bool skip_ctx_tile(int mt, bool last) { return last && (mt % (J / 128)) < (LC / 128); }
__device__ __forceinline__ int n_tiles(bool last) { return last ? NB * (S / 128) : R / 128; }
__device__ __forceinline__ int tile_of(int v, bool last) { return last ? (v / (S / 128)) * (J / 128) + LC / 128 + v % (S / 128) : v; }
__device__ __forceinline__ void phase_outproj(const Params& p, int layer, bool last, int bid, int nb, unsigned char* lds) {
    const bf16_t* M = (const bf16_t*)(p.ws + WS_H); const bf16_t* W = (const bf16_t*)(p.ws + WS_WOUT) + (size_t)layer * D * MIXW; const float* SSi = (const float*)(p.ws + WS_SS);
    constexpr int NT = D / 256; const int all = n_tiles(last) * NT, total = all >= nb ? (all / nb) * nb : all, remu = all - total;
    FOR_UNITS(v, remu * 4) {
        const int u = total + (v >> 2), part = v & 3, mt = tile_of(u / NT, last), nt = u % NT, cbase = nt * 256 + part * 64;
        const int tid_ = tidx(), wr_ = (tid_ >> 6) >> 1, fr_ = tid_ & 15;
        float* gs = (float*)(lds + 74240);
        if (tid_ < 128) { const f32x4* s4 = (const f32x4*)(SSi + (size_t)(mt * 128 + tid_) * SSW);
            const f32x4 sa = s4[0], sb = s4[1]; f32x4 sc = s4[2];
#pragma unroll
            for (int i = 3; i < SSW / 4; ++i) sc += s4[i];
            const float m0 = ((sa[0] + sa[1]) + (sa[2] + sa[3])) * (1.0f / 256.0f) + EPS, m1 = ((sb[0] + sb[1]) + (sb[2] + sb[3])) * (1.0f / 256.0f) + EPS;
            const float m2 = ((sc[0] + sc[1]) + (sc[2] + sc[3])) * (1.0f / 512.0f) + EPS;
            gs[tid_] = sqrtf(m1 / m0); gs[128 + tid_] = sqrtf(m2 / m1); gs[256 + tid_] = fast_rsqrt(m2); }
        __syncthreads();
        auto ap = [&](int r) -> const bf16_t* { return M + (size_t)(mt * 128 + r) * MIXW; };
        auto bp = [&](int n) -> const bf16_t* { return W + (size_t)(cbase + n) * MIXW; };
        auto gsf = [&](auto gtag, int mi) -> float { return gs[decltype(gtag)::value * 128 + wr_ * 64 + mi * 16 + fr_]; };
        auto epi = [&](const f32x4 (&acc)[4][2], int wr, int wc, int fr, int fq) {
#pragma unroll
            for (int mi = 0; mi < 4; ++mi) { const int row = mt * 128 + wr * 64 + mi * 16 + fr; const float* gt = mod_ptr(p, layer, mod_index(row), 2);
                { f32x4 lo = acc[mi][0], hi = acc[mi][1]; widen_acc(lo, hi);
                  resid8<true>(p, layer, row, cbase + wc * 32 + (fq & 1) * 16 + (fq & 2) * 4, gt, lo, hi); } }
        };
        gemm_tile<2, true>(ap, bp, bp, MIXW, MIXW / 64, lds, gsf, epi);
        __syncthreads();
    }
    FOR_UNITS(u, total) {
        const int mt = tile_of(u / NT, last), nt = u % NT;
        const int tid_ = tidx(), wr_ = (tid_ >> 6) >> 1, fr_ = tid_ & 15;
        float* gs = (float*)(lds + 74240);
        if (tid_ < 128) { const f32x4* s4 = (const f32x4*)(SSi + (size_t)(mt * 128 + tid_) * SSW);
            const f32x4 sa = s4[0], sb = s4[1]; f32x4 sc = s4[2];
#pragma unroll
            for (int i = 3; i < SSW / 4; ++i) sc += s4[i];
            const float m0 = ((sa[0] + sa[1]) + (sa[2] + sa[3])) * (1.0f / 256.0f) + EPS, m1 = ((sb[0] + sb[1]) + (sb[2] + sb[3])) * (1.0f / 256.0f) + EPS;
            const float m2 = ((sc[0] + sc[1]) + (sc[2] + sc[3])) * (1.0f / 512.0f) + EPS;
            gs[tid_] = sqrtf(m1 / m0); gs[128 + tid_] = sqrtf(m2 / m1); gs[256 + tid_] = fast_rsqrt(m2); }
        __syncthreads();
        auto ap = [&](int r) -> const bf16_t* { return M + (size_t)(mt * 128 + r) * MIXW; };
        auto bp = [&](int n) -> const bf16_t* { return W + (size_t)(nt * 256 + n) * MIXW; };
        auto gsf = [&](auto gtag, int mi) -> float { return gs[decltype(gtag)::value * 128 + wr_ * 64 + mi * 16 + fr_]; };
        auto epi = [&](const f32x4 (&acc)[4][8], int wr, int wc, int fr, int fq) {
#pragma unroll
            for (int mi = 0; mi < 4; ++mi) { const int row = mt * 128 + wr * 64 + mi * 16 + fr; const float* gt = mod_ptr(p, layer, mod_index(row), 2);
#pragma unroll
                for (int np = 0; np < 4; ++np) { f32x4 lo = acc[mi][2 * np], hi = acc[mi][2 * np + 1]; widen_acc(lo, hi);
                    resid8<true>(p, layer, row, nt * 256 + wc * 128 + (2 * np + (fq & 1)) * 16 + (fq & 2) * 4, gt, lo, hi); }
#ifndef EMU
                asm volatile("" ::: "memory");
#endif
            }
        };
        gemm_tile2<true>(ap, bp, bp, MIXW, MIXW / 32, lds, gsf, epi);
    }
}

__device__ __forceinline__ void phase_norm2_route(const Params& p, int layer, bool last, int bid, int nb, unsigned char* lds) {
    bf16_t* H = (bf16_t*)(p.ws + WS_H); const bf16_t* W = (const bf16_t*)(p.ws + WS_WRT) + (size_t)layer * 64 * D;
    unsigned* cnt = (unsigned*)(p.ws + WS_CNT) + layer * 128; int* list = (int*)(p.ws + WS_LIST); float* lw = (float*)(p.ws + WS_LW);
    const int tid = tidx(), lane = tid & 63, w = tid >> 6;
    const int ntile = n_tiles(last), FT = ntile >= nb ? (ntile / nb) * nb : ntile, rem = ntile - FT;
    int SUBS = 1; while (SUBS < 16 && rem * SUBS * 2 <= nb) SUBS *= 2;
    const int total = FT + rem * SUBS;
    FOR_UNITS(u, total) {
        int rowbase, nrows;
        if (u < FT) { rowbase = tile_of(u, last) * 128; nrows = 128; }
        else { const int v2 = u - FT; nrows = 128 / SUBS; rowbase = tile_of(FT + v2 / SUBS, last) * 128 + (v2 % SUBS) * nrows; }
        const int rpw = nrows / 4;
        norm_run<0>(p, layer, p.in[7] + layer * D, 4, 3, rowbase + w * rpw, rowbase + w * rpw + rpw, lane, [&](int row, int k) { return xload4s(p, row, k); }, [&](int row) { return (void*)(H + (size_t)row * D); }, [&](int row) { return mod_index(row); });
        __syncthreads();
        float* lg = (float*)lds;
        const bf16_t* zrow = (const bf16_t*)(p.ws + WS_ZROW);
        auto ap = [&](int r) -> const bf16_t* { return r < nrows ? H + (size_t)(rowbase + r) * D : zrow; };
        auto bp = [&](int n) -> const bf16_t* { return n < 36 ? W + (size_t)n * D : zrow; };
        auto epi = [&](const f32x4 (&acc)[4][2], int wr, int wc, int fr, int fq) {
#pragma unroll
            for (int mi = 0; mi < 4; ++mi)
#pragma unroll
                for (int ni = 0; ni < 2; ++ni) { const int col = wc * 32 + ni * 16 + fq * 4; if (col < 40) *(f32x4*)(lg + (wr * 64 + mi * 16 + fr) * 40 + col) = acc[mi][ni]; }
        };
        gemm_tile<2, false>(ap, bp, bp, D, D / 64, lds, NoGS(), epi);
        __syncthreads();
        if (tid < nrows) { const int row = rowbase + tid; const float* l = lg + tid * 40;
            const float* b1 = p.in[24] + layer * 4; const float* b2 = p.in[26] + layer * 32;
            float g0 = l[0] + b1[0]; int g = 0;
#pragma unroll
            for (int i = 1; i < 4; ++i) { const float v = l[i] + b1[i]; if (v > g0) { g0 = v; g = i; } }
            float den = 0.f;
#pragma unroll
            for (int i = 0; i < 4; ++i) den += expf(l[i] + b1[i] - g0);
            const float pg = 1.0f / den;
            float e1 = -3.0e38f, e2 = -3.0e38f; int i1 = 0, i2 = 0;
#pragma unroll
            for (int i = 0; i < 8; ++i) { const float v = l[4 + g * 8 + i] + b2[g * 8 + i];
                if (v > e1) { e2 = e1; i2 = i1; e1 = v; i1 = i; } else if (v > e2) { e2 = v; i2 = i; } }
            const float w1 = 1.0f / (1.0f + expf(e2 - e1)), w2 = 1.0f - w1;
            const int lo = i1 < i2 ? i1 : i2, hi = i1 < i2 ? i2 : i1; const float wlo = i1 < i2 ? w1 : w2, whi = i1 < i2 ? w2 : w1;
            const int pair = g * 28 + lo * (15 - lo) / 2 + (hi - lo - 1);
            const unsigned slot = atomicAdd(cnt + pair, 1u);
            list[(size_t)pair * R + slot] = row; lw[(size_t)row * 2] = pg * wlo; lw[(size_t)row * 2 + 1] = pg * whi; }
        __syncthreads();
    }
}

__device__ __forceinline__ int build_tiles(const Params& p, int layer, int* tstart) {
    const unsigned* cnt = (const unsigned*)(p.ws + WS_CNT) + layer * 128;
    const int tid = tidx();
    if (tid < 128) {
        const int lane = tid & 63; int v = tid < NPAIR ? ((int)cnt[tid] + 127) >> 7 : 0; const int own = v;
#pragma unroll
        for (int o = 1; o < 64; o <<= 1) { const int t = __shfl_up(v, o); if (lane >= o) v += t; }
        if (tid < 64) { tstart[tid] = v - own; if (lane == 63) tstart[NPAIR + 2] = v; }
        else tstart[NPAIR + 4 + lane] = v - own;
    }
    __syncthreads();
    if (tid >= 64 && tid < 128) { const int lane = tid & 63, base = tstart[NPAIR + 2]; if (tid < NPAIR) tstart[tid] = base + tstart[NPAIR + 4 + lane];
        if (tid == NPAIR) tstart[NPAIR] = base + tstart[NPAIR + 4 + lane]; }
    __syncthreads();
    return tstart[NPAIR];
}
__device__ __forceinline__ void pair_experts(int pair, int& elo, int& ehi) {
    const int g = pair / 28; int r = pair % 28, lo = 0; while (r >= 7 - lo) { r -= 7 - lo; ++lo; } elo = g * 8 + lo; ehi = g * 8 + lo + 1 + r;
}
__device__ __forceinline__ int find_pair(const int* tstart, int t) {
    int lo = 0, hi = NPAIR - 1;
    while (lo < hi) { const int mid = (lo + hi + 1) >> 1; if (tstart[mid] <= t) lo = mid; else hi = mid - 1; }
    return lo; }
__device__ __forceinline__ void phase_moe_up(const Params& p, int layer, int bid, int nb, unsigned char* lds) {
    int* tstart = (int*)(lds + 73728); const int T = build_tiles(p, layer, tstart);
    const bf16_t* H = (const bf16_t*)(p.ws + WS_H); bf16_t* ACT = (bf16_t*)(p.ws + WS_Z);
    const unsigned* cnt = (const unsigned*)(p.ws + WS_CNT) + layer * 128; const int* list = (const int*)(p.ws + WS_LIST); const float* lw = (const float*)(p.ws + WS_LW);
    const int total = T * 4;
    FOR_UNITS(u, total) {
        const int t = u >> 2, nt = u & 3, pair = find_pair(tstart, t), tl = t - tstart[pair], n = (int)cnt[pair]; int elo, ehi; pair_experts(pair, elo, ehi);
        const int half = nt >> 1, e = half ? ehi : elo, cb = (nt & 1) * 128;
        const bf16_t* Wg = (const bf16_t*)(p.ws + WS_WEG) + ((size_t)layer * 32 + e) * DE * D; const bf16_t* Wu = (const bf16_t*)(p.ws + WS_WEU) + ((size_t)layer * 32 + e) * DE * D;
        const int* lst = list + (size_t)pair * R + tl * 128;
        const bf16_t* zrow = (const bf16_t*)(p.ws + WS_ZROW);
        auto ap = [&](int r) -> const bf16_t* { return tl * 128 + r < n ? H + (size_t)lst[tl * 128 + r < n ? r : 0] * D : zrow; };
        auto bp = [&](int nn) -> const bf16_t* { const int wc = nn >> 7, t128 = nn & 127, col = cb + wc * 64 + (t128 & 63); return ((t128 >> 6) ? Wu : Wg) + (size_t)col * D; };
        auto epi = [&](const f32x4 (&acc)[4][8], int wr, int wc, int fr, int fq) {
#pragma unroll
            for (int mi = 0; mi < 4; ++mi) { const int rl = wr * 64 + mi * 16 + fr; const bool okr = tl * 128 + rl < n;
                const float cw = okr ? lw[(size_t)lst[okr ? rl : 0] * 2 + half] : 0.f;
#pragma unroll
                for (int np = 0; np < 2; ++np) { u32x2 pk[2];
#pragma unroll
                    for (int h2 = 0; h2 < 2; ++h2) { const f32x4 g = acc[mi][2 * np + h2], uu = acc[mi][2 * np + h2 + 4]; float o[4];
#pragma unroll
                        for (int e4 = 0; e4 < 4; ++e4) o[e4] = siluf_(g[e4]) * uu[e4] * cw;
                        pk[h2] = (u32x2){pack2(o[0], o[1]), pack2(o[2], o[3])}; }
                    const u32x4 ow = widen_pair(pk[0], pk[1]);
                    if (okr) *(u32x4*)(ACT + (size_t)(t * 128 + rl) * 512 + half * 256 + cb + wc * 64 + (2 * np + (fq & 1)) * 16 + (fq & 2) * 4) = ow; } }
        };
        gemm_tile2<false>(ap, bp, bp, D, D / 32, lds, NoGS(), epi);
    }
}
__device__ __forceinline__ void phase_moe_down(const Params& p, int layer, int bid, int nb, unsigned char* lds) {
    int* tstart = (int*)(lds + 73728); const int T = build_tiles(p, layer, tstart);
    const bf16_t* ACT = (const bf16_t*)(p.ws + WS_Z);
    const unsigned* cnt = (const unsigned*)(p.ws + WS_CNT) + layer * 128; const int* list = (const int*)(p.ws + WS_LIST);
    constexpr int NT = D / 256; const int total = T * NT;
    FOR_UNITS(u, total) {
        const int t = u / NT, nt = u % NT, pair = find_pair(tstart, t), tl = t - tstart[pair], n = (int)cnt[pair]; int elo, ehi; pair_experts(pair, elo, ehi);
        const bf16_t* W0 = (const bf16_t*)(p.ws + WS_WED) + ((size_t)layer * 32 + elo) * D * DE; const bf16_t* W1 = (const bf16_t*)(p.ws + WS_WED) + ((size_t)layer * 32 + ehi) * D * DE;
        const int* lst = list + (size_t)pair * R + tl * 128;
        const bf16_t* zrow = (const bf16_t*)(p.ws + WS_ZROW);
        auto ap = [&](int r) -> const bf16_t* { return tl * 128 + r < n ? ACT + (size_t)(t * 128 + r) * 512 : zrow; };
        auto bp = [&](int nn) -> const bf16_t* { return W0 + (size_t)(nt * 256 + nn) * DE; };
        auto bp2 = [&](int nn) -> const bf16_t* { return W1 + (size_t)(nt * 256 + nn) * DE; };
        auto epi = [&](const f32x4 (&acc)[4][8], int wr, int wc, int fr, int fq) {
#pragma unroll
            for (int mi = 0; mi < 4; ++mi) { const int rl = wr * 64 + mi * 16 + fr; const bool okr = tl * 128 + rl < n;
                const int row = lst[okr ? rl : 0]; const float* gt = mod_ptr(p, layer, mod_index(row), 5);
#pragma unroll
                for (int np = 0; np < 4; ++np) { f32x4 lo = acc[mi][2 * np], hi = acc[mi][2 * np + 1]; widen_acc(lo, hi);
                    if (okr) resid8<false>(p, layer, row, nt * 256 + wc * 128 + (2 * np + (fq & 1)) * 16 + (fq & 2) * 4, gt, lo, hi); }
#ifndef EMU
                asm volatile("" ::: "memory");
#endif
            }
        };
        gemm_tile2<false>(ap, bp, bp2, 512, 8, lds, NoGS(), epi);
    }
}

constexpr int LDS_BYTES = 75792;
#ifndef EMU
#define XB_TMO      128
#define XB_XCNT(j)  (256  + 64 * (j))
#define XB_XSUB(j)  (1280 + 64 * (j))
#define XB_XGEN(j)  (2304 + 64 * (j))
#define XB_TOP      3328
#define XB_TOPGEN   3392
#define XCD_BAR_WORDS 3456
#define XB_SPIN_CAP (1u << 18)
#define LAS __attribute__((address_space(3)))
static_assert(XCD_BAR_WORDS == XCD_BAR_WORDS_C, "barrier words");

__device__ __forceinline__ unsigned xb_ld(unsigned* p)              { return __hip_atomic_load(p, __ATOMIC_RELAXED, __HIP_MEMORY_SCOPE_AGENT); }
__device__ __forceinline__ unsigned xb_add(unsigned* p, unsigned v) { return __hip_atomic_fetch_add(p, v, __ATOMIC_RELAXED, __HIP_MEMORY_SCOPE_AGENT); }
__device__ __forceinline__ unsigned xb_xcc_id() { return (unsigned)__builtin_amdgcn_s_getreg((3 << 11) | 20) & 0xFu; }
#define XB_SPIN(cond, bar) do { unsigned _sp = 0; while (cond) { __builtin_amdgcn_s_sleep(1); \
    if ((++_sp & 255u) == 0u) { if (xb_ld(&(bar)[XB_TMO])) break; if (_sp > XB_SPIN_CAP) { atomicAdd(&(bar)[XB_TMO], 1u); break; } } } } while (0)

struct XcdBarrier { unsigned* bar; unsigned x; volatile LAS unsigned* st; };

__device__ __forceinline__ XcdBarrier xcd_barrier_post(unsigned* bar, volatile LAS unsigned* st) {
    XcdBarrier b; b.bar = bar; b.x = xb_xcc_id(); b.st = st;
    if (threadIdx.x == 0) (void)xb_add(&bar[XB_XCNT(b.x)], 1u);
    return b;
}
__device__ __forceinline__ void xcd_barrier_complete(unsigned* bar, unsigned x, unsigned& nloc, unsigned& nx) {
    const unsigned G = gridDim.x * gridDim.y * gridDim.z;
    unsigned sum, cnt, mine, sp = 0u;
    for (;;) {
        sum = 0u; cnt = 0u; mine = 0u;
#pragma unroll
        for (unsigned j = 0; j < 16; ++j) { const unsigned c = xb_ld(&bar[XB_XCNT(j)]); sum += c; cnt += (c > 0u) ? 1u : 0u; mine = (j == x) ? c : mine; }
        if (sum == G) break;
        __builtin_amdgcn_s_sleep(1);
        if ((++sp & 255u) == 0u) { if (xb_ld(&bar[XB_TMO])) break; if (sp > XB_SPIN_CAP) { atomicAdd(&bar[XB_TMO], 1u); break; } }
    }
    nloc = mine > 0u ? mine : 1u; nx = cnt > 0u ? cnt : 1u;
}
__device__ __forceinline__ void xcd_barrier(const XcdBarrier& b) {
    asm volatile("s_waitcnt vmcnt(0)" ::: "memory");
    __syncthreads();
    if (threadIdx.x == 0) {
        unsigned* bar = b.bar;
        __builtin_amdgcn_s_waitcnt(0);
        unsigned nloc = b.st[0], nx = b.st[1];
        if (nloc == 0u) { xcd_barrier_complete(bar, b.x, nloc, nx); b.st[0] = nloc; b.st[1] = nx; }
        const unsigned old = xb_add(&bar[XB_XSUB(b.x)], 1u);
        const unsigned gen = old / nloc;
        if (old + 1u == (gen + 1u) * nloc) {
            __builtin_amdgcn_fence(__ATOMIC_RELEASE, "agent");
            asm volatile("s_waitcnt vmcnt(0)" ::: "memory");
            const unsigned og = xb_add(&bar[XB_TOP], 1u);
            const unsigned tg = og / nx;
            if (og + 1u == (tg + 1u) * nx) xb_add(&bar[XB_TOPGEN], 1u);
            else XB_SPIN(xb_ld(&bar[XB_TOPGEN]) == tg, bar);
            __builtin_amdgcn_fence(__ATOMIC_ACQUIRE, "agent");
            xb_add(&bar[XB_XGEN(b.x)], 1u);
            asm volatile("s_waitcnt vmcnt(0)" ::: "memory");
        } else {
            XB_SPIN(xb_ld(&bar[XB_XGEN(b.x)]) == gen, bar);
            __builtin_amdgcn_fence(__ATOMIC_ACQUIRE, "agent");
            asm volatile("s_waitcnt vmcnt(0)" ::: "memory");
        }
    }
    __syncthreads();
}

__global__ void __launch_bounds__(NTHREADS, 2) fwd_kernel(Params p) {
    unsigned char* lds = SMEM_PTR();
    volatile LAS unsigned* st = (volatile LAS unsigned*)(lds + LDS_BYTES - 16);
    if (threadIdx.x == 0) { st[0] = 0u; st[1] = 0u; st[2] = 0u; st[3] = 0u; }
    __syncthreads();
    XcdBarrier bar = xcd_barrier_post((unsigned*)(p.ws + WS_BAR), st);
    const int bid = blockIdx.x, nb = gridDim.x;
    phase_prologue(p, bid, nb, lds);
    xcd_barrier(bar);
    for (int layer = 0; layer < DEPTH; ++layer) {
        const bool last = layer == DEPTH - 1;
        phase_norm1(p, layer, bid, nb);                  xcd_barrier(bar);
#if PROBE == 7
        phase_norm1(p, layer, bid, nb);                  xcd_barrier(bar);
#endif
        phase_inproj(p, layer, bid, nb, lds);            xcd_barrier(bar);
#if PROBE == 3
        phase_inproj(p, layer, bid, nb, lds);            xcd_barrier(bar);
#endif
        phase_prep(p, layer, last, bid, nb, lds);        xcd_barrier(bar);
#if PROBE == 6
        { FOR_UNITS(u, N_PQ) prep_q_unit(p, layer, u, lds); }
        { FOR_UNITS_ROT(u, N_PKV, 2) prep_kv_unit(p, layer, u, lds); }
        { FOR_UNITS_ROT(u, N_PR, 4) prep_rope_unit(p, u, lds); }
        xcd_barrier(bar);
#endif
        phase_attn_a(p, layer, last, bid, nb, lds);
        phase_attn_b(p, layer, last, bid, nb, lds);      xcd_barrier(bar);
#if PROBE == 4
        phase_attn_a(p, layer, last, bid, nb, lds);      xcd_barrier(bar);
#endif
#if PROBE == 8
        phase_attn_b(p, layer, last, bid, nb, lds);      xcd_barrier(bar);
#endif
        phase_outproj(p, layer, last, bid, nb, lds);     xcd_barrier(bar);
        phase_norm2_route(p, layer, last, bid, nb, lds); xcd_barrier(bar);
        phase_moe_up(p, layer, bid, nb, lds);            xcd_barrier(bar);
#if PROBE == 5
        phase_moe_up(p, layer, bid, nb, lds);            xcd_barrier(bar);
#endif
        phase_moe_down(p, layer, bid, nb, lds);          xcd_barrier(bar);
    }
    phase_final(p, bid, nb);
}

extern "C" void kernel_launch(void* const* d_in, const int* in_sizes, int n_in, void* d_out, int out_size, void* d_ws, size_t ws_size, hipStream_t stream) {
    static int grid = 0;
    if (grid == 0) {
        if (n_in != 31 || out_size != NB * S * D || ws_size < WS_END) { fprintf(stderr, "kernel_launch: unexpected shapes (n_in %d out %d ws %zu need %zu)\n", n_in, out_size, ws_size, (size_t)WS_END); grid = -1; return; }
        int dev = 0, cus = 0, per_cu = 0;
        if (hipGetDevice(&dev) != hipSuccess || hipDeviceGetAttribute(&cus, hipDeviceAttributeMultiprocessorCount, dev) != hipSuccess) { grid = -1; return; }
        if (hipFuncSetAttribute((const void*)fwd_kernel, hipFuncAttributeMaxDynamicSharedMemorySize, LDS_BYTES) != hipSuccess) { fprintf(stderr, "kernel_launch: hipFuncSetAttribute failed\n"); grid = -1; return; }
        if (hipOccupancyMaxActiveBlocksPerMultiprocessor(&per_cu, (const void*)fwd_kernel, NTHREADS, LDS_BYTES) != hipSuccess || per_cu < 1) { fprintf(stderr, "kernel_launch: occupancy query failed (%d)\n", per_cu); per_cu = 1; }
        (void)hipGetLastError();
        grid = cus * (per_cu < 2 ? per_cu : 2);
    }
    if (grid < 0) return;
    (void)in_sizes;
    if (hipMemsetAsync(d_ws, 0, WS_ZERO_BYTES, stream) != hipSuccess) return;
    Params p{};
    for (int i = 0; i < 31; ++i) p.in[i] = (const float*)d_in[i];
    p.out = (float*)d_out; p.ws = (unsigned char*)d_ws;
    hipLaunchKernelGGL(fwd_kernel, dim3(grid), dim3(NTHREADS), LDS_BYTES, stream, p);
}
#endif
```

```cpp
#ifndef EMU
#include <hip/hip_runtime.h>
#endif
#include <cstdint>
#include <cstdio>
#include <type_traits>

#ifndef CFG_TINY
constexpr int D = 1024, NB = 16, S = 4096, LC = 256, DEPTH = 2;
#else
constexpr int D = 256, NB = 2, S = 768, LC = 256, DEPTH = 2;
#endif
constexpr int GW = 64;
constexpr int J = LC + S;
constexpr int R = NB * J;
constexpr int INC = 1952;
constexpr int C_CQ = 0, C_CKV = 256, C_KR = 384, C_SQ = 416, C_SK = 672, C_SV = 800, C_LX = 928, C_LG = 1440;
constexpr int MIXW = 1024;
constexpr int NPAIR = 112;
constexpr int DE = 256;
#ifndef PROBE
#define PROBE 0
#endif
constexpr float EPS = 1e-6f;
constexpr float LOG2E = 1.4426950408889634f;
constexpr int NTHREADS = 256;
static_assert(J % 256 == 0 && LC % 256 == 0 && S % 64 == 0 && D % 64 == 0, "tile divisibility");

typedef unsigned short bf16_t;
#ifndef EMU
typedef short bf16x8 __attribute__((ext_vector_type(8)));
typedef float f32x4 __attribute__((ext_vector_type(4)));
typedef float f32x16 __attribute__((ext_vector_type(16)));
#endif
typedef unsigned u32x4 __attribute__((ext_vector_type(4)));
typedef unsigned u32x2 __attribute__((ext_vector_type(2)));
typedef float f32x2 __attribute__((ext_vector_type(2)));

constexpr size_t al256(size_t x) { return (x + 255) & ~(size_t)255; }
constexpr int XCD_BAR_WORDS_C = 3456;
constexpr size_t WS_BAR = 0;
constexpr size_t WS_CNT = al256(WS_BAR + XCD_BAR_WORDS_C * 4);
constexpr size_t WS_ZROW = al256(WS_CNT + DEPTH * 128 * 4);
constexpr size_t WS_ZERO_BYTES = al256(WS_ZROW + 4096);
constexpr size_t WS_MOD = WS_ZERO_BYTES;
constexpr size_t WS_ROPE = al256(WS_MOD + (size_t)DEPTH * 17 * 6 * D * 4);
constexpr size_t WS_WIN = al256(WS_ROPE + (64 * 16 * 2 + 64 * 8 * 2) * 4);
constexpr size_t WS_WUQ = al256(WS_WIN + (size_t)DEPTH * 2048 * D * 2);
constexpr size_t WS_WUKV = al256(WS_WUQ + (size_t)DEPTH * 384 * 256 * 2);
constexpr size_t WS_WOUT = al256(WS_WUKV + (size_t)DEPTH * 512 * 128 * 2);
constexpr size_t WS_WLRU = al256(WS_WOUT + (size_t)DEPTH * D * MIXW * 2);
constexpr size_t WS_WRT = al256(WS_WLRU + (size_t)DEPTH * 8 * 2 * 4 * 2 * 4096 * 2);
constexpr size_t WS_WEG = al256(WS_WRT + (size_t)DEPTH * 64 * D * 2);
constexpr size_t WS_WEU = al256(WS_WEG + (size_t)DEPTH * 32 * DE * D * 2);
constexpr size_t WS_WED = al256(WS_WEU + (size_t)DEPTH * 32 * DE * D * 2);
constexpr size_t WS_X = al256(WS_WED + (size_t)DEPTH * 32 * D * DE * 2);
constexpr size_t WS_H = al256(WS_X + (size_t)R * D * 2);
constexpr size_t WS_Z = al256(WS_H + (size_t)R * (D > MIXW ? D : MIXW) * 2);
constexpr int ACT_ROWS = R + NPAIR * 128;
constexpr size_t Z_BYTES = (size_t)R * INC * 2 > (size_t)ACT_ROWS * 512 * 2 ? (size_t)R * INC * 2 : (size_t)ACT_ROWS * 512 * 2;
constexpr size_t WS_ZSS = al256(WS_Z + Z_BYTES);
constexpr size_t WS_Q = al256(WS_ZSS + (size_t)R * 8 * 4);
constexpr size_t WS_KN = al256(WS_Q + (size_t)NB * 4 * J * 96 * 2);
constexpr size_t WS_KR = al256(WS_KN + (size_t)NB * 4 * J * 64 * 2);
constexpr size_t WS_VT = al256(WS_KR + (size_t)NB * J * 32 * 2);
constexpr size_t WS_SQ = al256(WS_VT + (size_t)NB * 4 * 64 * J * 2);
constexpr size_t WS_SK = al256(WS_SQ + (size_t)NB * 4 * J * 64 * 2);
constexpr size_t WS_SVT = al256(WS_SK + (size_t)NB * 2 * J * 64 * 2);
constexpr int SSW = 40;
constexpr size_t WS_SS = al256(WS_SVT + (size_t)NB * 2 * 64 * J * 2);
constexpr size_t WS_HF = al256(WS_SS + (size_t)R * SSW * 4);
constexpr size_t WS_LIST = al256(WS_HF + (size_t)NB * 512 * J * 2);
constexpr size_t WS_LW = al256(WS_LIST + (size_t)NPAIR * R * 4);
constexpr size_t WS_END = al256(WS_LW + (size_t)R * 2 * 4);
static_assert(WS_END <= ((size_t)1 << 30), "workspace = 4 x the output");

struct Params {
    const float* in[31];
    float* out;
    unsigned char* ws;
};

#ifdef EMU
#define GLDS16(gp, lp) memcpy((void*)(lp), (const void*)(gp), 16)
#define WAIT_VM(n) do {} while (0)
#define RAW_BARRIER() emu_block_barrier()
#define SETPRIO(n) do {} while (0)
#define SCHED_FENCE() do {} while (0)
#define PIN1(a) do {} while (0)
#define PIN2(a, b) do {} while (0)
#define MFMA16(a, b, c) emu_mfma16(a, b, c)
#define MFMA32(a, b, c) emu_mfma32(a, b, c)
#define SMEM_PTR() emu_lds()
static inline float fast_exp2(float x) { return exp2f(x); }
static inline float fast_rcp(float x) { return 1.0f / x; }
static inline float fast_rsqrt(float x) { return 1.0f / sqrtf(x); }
static inline float fast_sqrt(float x) { return sqrtf(x); }
#else
#define GLDS16(gp, lp) __builtin_amdgcn_global_load_lds((const __attribute__((address_space(1))) unsigned*)(gp), (__attribute__((address_space(3))) unsigned*)(lp), 16, 0, 0)
#define WAIT_VM(n) asm volatile("s_waitcnt vmcnt(" #n ")" ::: "memory")
#define RAW_BARRIER() do { asm volatile("" ::: "memory"); __builtin_amdgcn_s_barrier(); asm volatile("" ::: "memory"); } while (0)
#define SCHED_FENCE() __builtin_amdgcn_sched_barrier(0)
#define SETPRIO(n) __builtin_amdgcn_s_setprio(n)
#define PIN1(a) asm volatile("" : "+v"(a))
#define PIN2(a, b) asm volatile("" : "+v"(a), "+v"(b))
#define MFMA16(a, b, c) __builtin_amdgcn_mfma_f32_16x16x32_bf16(a, b, c, 0, 0, 0)
#define MFMA32(a, b, c) __builtin_amdgcn_mfma_f32_32x32x16_bf16(a, b, c, 0, 0, 0)
extern __shared__ __attribute__((aligned(16))) unsigned char smem_raw[];
#define SMEM_PTR() smem_raw
__device__ __forceinline__ float fast_exp2(float x) { return __builtin_amdgcn_exp2f(x); }
__device__ __forceinline__ float fast_rcp(float x) { return __builtin_amdgcn_rcpf(x); }
__device__ __forceinline__ float fast_rsqrt(float x) { return __builtin_amdgcn_rsqf(x); }
__device__ __forceinline__ float fast_sqrt(float x) { return __builtin_amdgcn_sqrtf(x); }
#endif

#ifdef EMU
__device__ __forceinline__ bf16_t f2bf(float f) {
    unsigned u = __builtin_bit_cast(unsigned, f);
    u += 0x7FFFu + ((u >> 16) & 1u);
    return (bf16_t)(u >> 16);
}
__device__ __forceinline__ unsigned pack2(float lo, float hi) { return (unsigned)f2bf(lo) | ((unsigned)f2bf(hi) << 16); }
#else
typedef __bf16 bf16x2_t __attribute__((ext_vector_type(2)));
__device__ __forceinline__ bf16_t f2bf(float f) { return __builtin_bit_cast(bf16_t, (__bf16)f); }
__device__ __forceinline__ unsigned pack2(float lo, float hi) { bf16x2_t v; v[0] = (__bf16)lo; v[1] = (__bf16)hi; return __builtin_bit_cast(unsigned, v); }
#endif
__device__ __forceinline__ float bf2f(bf16_t h) { return __builtin_bit_cast(float, ((unsigned)h) << 16); }
__device__ __forceinline__ float sigmoidf_(float x) { return fast_rcp(1.0f + fast_exp2(-x * LOG2E)); }
__device__ __forceinline__ float siluf_(float x) { return x * sigmoidf_(x); }
__device__ __forceinline__ float gelu_tanh(float x) {
    const float u = 0.7978845608028654f * (x + 0.044715f * x * x * x);
    const float t = 1.0f - 2.0f * fast_rcp(fast_exp2(2.0f * LOG2E * u) + 1.0f);
    return 0.5f * x * (1.0f + t);
}

#ifdef EMU
static inline int tidx() { return (int)threadIdx.x; }
#else
__device__ __forceinline__ int tidx() { int t = threadIdx.x; asm volatile("" : "+v"(t)); return t; }
#endif

__device__ __forceinline__ const float* xin_row(const Params& p, int row) {
    const int b = row / J, j = row - b * J;
    return j < LC ? p.in[2] + ((size_t)b * LC + j) * D : p.in[0] + ((size_t)b * S + (j - LC)) * D;
}
__device__ __forceinline__ bf16_t* xrow(const Params& p, int row) { return (bf16_t*)(p.ws + WS_X) + (size_t)row * D; }
__device__ __forceinline__ f32x4 xload4(const Params& p, int layer, int row, int col) {
    if (layer == 0) return *(const f32x4*)(xin_row(p, row) + col);
    const u32x2 w = *(const u32x2*)(xrow(p, row) + col);
    return (f32x4){bf2f((bf16_t)(w[0] & 0xffff)), bf2f((bf16_t)(w[0] >> 16)), bf2f((bf16_t)(w[1] & 0xffff)), bf2f((bf16_t)(w[1] >> 16))};
}
__device__ __forceinline__ f32x4 xload4s(const Params& p, int row, int col) {
    const u32x2 w = *(const u32x2*)(xrow(p, row) + col);
    return (f32x4){bf2f((bf16_t)(w[0] & 0xffff)), bf2f((bf16_t)(w[0] >> 16)), bf2f((bf16_t)(w[1] & 0xffff)), bf2f((bf16_t)(w[1] >> 16))};
}
__device__ __forceinline__ void xstore4(const Params& p, int row, int col, f32x4 v) { *(u32x2*)(xrow(p, row) + col) = (u32x2){pack2(v[0], v[1]), pack2(v[2], v[3])}; }
__device__ __forceinline__ int mod_index(int row) { const int b = row / J, j = row - b * J; return j < LC ? NB : b; }
__device__ __forceinline__ const float* mod_ptr(const Params& p, int layer, int mi, int which) {
    return (const float*)(p.ws + WS_MOD) + ((size_t)(layer * 17 + mi) * 6 + which) * D;
}

template <bool FROM_IN>
__device__ __forceinline__ void resid8(const Params& p, int layer, int row, int col, const float* gt, f32x4 lo, f32x4 hi) {
    f32x4 x0, x1;
    if (FROM_IN && layer == 0) { x0 = *(const f32x4*)(xin_row(p, row) + col); x1 = *(const f32x4*)(xin_row(p, row) + col + 4); }
    else { const u32x4 w = *(const u32x4*)(xrow(p, row) + col);
        x0 = (f32x4){__builtin_bit_cast(float, w[0] << 16), __builtin_bit_cast(float, w[0] & 0xffff0000u), __builtin_bit_cast(float, w[1] << 16), __builtin_bit_cast(float, w[1] & 0xffff0000u)};
        x1 = (f32x4){__builtin_bit_cast(float, w[2] << 16), __builtin_bit_cast(float, w[2] & 0xffff0000u), __builtin_bit_cast(float, w[3] << 16), __builtin_bit_cast(float, w[3] & 0xffff0000u)}; }
    const f32x4 g0 = *(const f32x4*)(gt + col), g1 = *(const f32x4*)(gt + col + 4);
    const f32x4 o0 = x0 + g0 * lo, o1 = x1 + g1 * hi;
    *(u32x4*)(xrow(p, row) + col) = (u32x4){pack2(o0[0], o0[1]), pack2(o0[2], o0[3]), pack2(o1[0], o1[1]), pack2(o1[2], o1[3])};
}

__device__ __forceinline__ void swap16(unsigned& a, unsigned& b) {
#ifdef EMU
    const int l_ = emu_lane(); const unsigned pa = emu_shfl_u(a, l_ ^ 16), pb = emu_shfl_u(b, l_ ^ 16);
    if ((l_ >> 4) & 1) a = pb; else b = pa;
#else
    const auto r = __builtin_amdgcn_permlane16_swap(a, b, false, false); a = r[0]; b = r[1];
#endif
}
__device__ __forceinline__ void swap32(unsigned& a, unsigned& b) {
#ifdef EMU
    const int l_ = emu_lane(); const unsigned pa = emu_shfl_u(a, l_ ^ 32), pb = emu_shfl_u(b, l_ ^ 32);
    if (l_ >> 5) a = pb; else b = pa;
#else
    const auto r = __builtin_amdgcn_permlane32_swap(a, b, false, false); a = r[0]; b = r[1];
#endif
}
__device__ __forceinline__ u32x4 widen_pair32(u32x2 A, u32x2 B) { unsigned a0 = A[0], a1 = A[1], b0 = B[0], b1 = B[1]; swap32(a0, b0); swap32(a1, b1); return (u32x4){a0, a1, b0, b1}; }
__device__ __forceinline__ u32x4 widen_pair(u32x2 A, u32x2 B) { unsigned a0 = A[0], a1 = A[1], b0 = B[0], b1 = B[1]; swap16(a0, b0); swap16(a1, b1); return (u32x4){a0, a1, b0, b1}; }
__device__ __forceinline__ void widen_acc(f32x4& a, f32x4& b) {
#pragma unroll
    for (int e = 0; e < 4; ++e) { const float fa = a[e], fb = b[e]; unsigned ua = __builtin_bit_cast(unsigned, fa), ub = __builtin_bit_cast(unsigned, fb); swap16(ua, ub);
        const float ra = __builtin_bit_cast(float, ua), rb = __builtin_bit_cast(float, ub); a[e] = ra; b[e] = rb; }
}
struct NoGS { template <class T> __device__ __forceinline__ float operator()(T, int) const { return 1.f; } };
template <int WN, bool GS, class AP, class BP, class BP2, class GSF, class EPI>
__device__ __forceinline__ void gemm_tile(const AP& ap, const BP& bp, const BP2& bp2, const int K, const int ksplit, unsigned char* lds, const GSF& gsf, const EPI& epi) {
    constexpr int NBP = WN;
    const int tid = tidx(), lane = tid & 63, wid = tid >> 6, wr = wid >> 1, wc = wid & 1, fr = lane & 15, fq = lane >> 4;
    const int lr = tid >> 3, ch = tid & 7;
    const bf16_t* aptr[4]; const bf16_t* bptr[NBP]; const bf16_t* bptr2[NBP];
#pragma unroll
    for (int i = 0; i < 4; ++i) aptr[i] = ap(lr + 32 * i) + ch * 8;
#pragma unroll
    for (int i = 0; i < NBP; ++i) { bptr[i] = bp(lr + 32 * i) + ch * 8; bptr2[i] = bp2(lr + 32 * i) + ch * 8 - ksplit * 64; }
    const int wofs = lr * 128 + ((ch ^ (lr & 7)) << 4);
    f32x4 acc[4][WN];
#pragma unroll
    for (int mi = 0; mi < 4; ++mi)
#pragma unroll
        for (int ni = 0; ni < WN; ++ni) acc[mi][ni] = (f32x4){0.f, 0.f, 0.f, 0.f};
    const int KT = K / 64;
    u32x4 ra0[4], rb0[NBP], ra1[4], rb1[NBP];
    auto gl = [&](u32x4 (&ra)[4], u32x4 (&rb)[NBP], int kt) {
#pragma unroll
        for (int i = 0; i < 4; ++i) ra[i] = *(const u32x4*)(aptr[i] + kt * 64);
#pragma unroll
        for (int i = 0; i < NBP; ++i) { const bf16_t* q = (kt < ksplit) ? bptr[i] : bptr2[i]; rb[i] = *(const u32x4*)(q + kt * 64); }
    };
    auto sw = [&](const u32x4 (&ra)[4], const u32x4 (&rb)[NBP], int st) {
#pragma unroll
        for (int i = 0; i < 4; ++i) *(u32x4*)(lds + st * 16384 + wofs + i * 4096) = ra[i];
#pragma unroll
        for (int i = 0; i < NBP; ++i) *(u32x4*)(lds + 32768 + st * 16384 + wofs + i * 4096) = rb[i];
    };
    auto compute = [&](int st, int kt) {
        const unsigned char* As = lds + st * 16384;
        const unsigned char* Bs = lds + 32768 + st * 16384;
#pragma unroll
        for (int ks = 0; ks < 2; ++ks) {
            bf16x8 af[4], bfr[WN];
            const int sw_ = ((ks * 4 + fq) ^ (fr & 7)) << 4;
#pragma unroll
            for (int mi = 0; mi < 4; ++mi) af[mi] = *(const bf16x8*)(As + (wr * 64 + mi * 16 + fr) * 128 + sw_);
#pragma unroll
            for (int ni = 0; ni < WN; ++ni) bfr[ni] = *(const bf16x8*)(Bs + (wc * 16 * WN + ni * 16 + fr) * 128 + sw_);
            SETPRIO(1);
#pragma unroll
            for (int mi = 0; mi < 4; ++mi)
#pragma unroll
                for (int ni = 0; ni < WN; ++ni) acc[mi][ni] = MFMA16(bfr[ni], af[mi], acc[mi][ni]);
            SETPRIO(0);
        }
        if (GS) {
            auto scale = [&](auto gtag) {
#pragma unroll
                for (int mi = 0; mi < 4; ++mi) { const float sc = gsf(gtag, mi);
#pragma unroll
                    for (int ni = 0; ni < WN; ++ni) acc[mi][ni] *= sc; }
            };
            if (kt == 3) scale(std::integral_constant<int, 0>());
            else if (kt == 7) scale(std::integral_constant<int, 1>());
            else if (kt == KT - 1) scale(std::integral_constant<int, 2>());
        }
    };
    gl(ra0, rb0, 0);
    if (KT > 1) gl(ra1, rb1, 1);
    sw(ra0, rb0, 0);
    if (KT > 2) gl(ra0, rb0, 2);
    __syncthreads();
    for (int kt = 0; kt < KT; kt += 2) {
        compute(0, kt);
        if (kt + 1 < KT) { sw(ra1, rb1, 1); if (kt + 3 < KT) gl(ra1, rb1, kt + 3); }
        __syncthreads();
        if (kt + 1 < KT) {
            compute(1, kt + 1);
            if (kt + 2 < KT) { sw(ra0, rb0, 0); if (kt + 4 < KT) gl(ra0, rb0, kt + 4); }
            __syncthreads();
        }
    }
    epi(acc, wr, wc, fr, fq);
}

__device__ __forceinline__ int swz4(int row) { return (0x78 >> (((row >> 2) & 3) * 2)) & 3; }
template <bool GS, class AP, class BP, class BP2, class GSF, class EPI>
__device__ __forceinline__ void gemm_tile2(const AP& ap, const BP& bp, const BP2& bp2, const int K, const int ksplit, unsigned char* lds, const GSF& gsf, const EPI& epi) {
    const int tid = tidx(), lane = tid & 63, wid = tid >> 6, wr = wid >> 1, wc = wid & 1, fr = lane & 15, fq = lane >> 4;
    const int rl = lane >> 2, cp = lane & 3;
    const bf16_t* asrc[2]; const bf16_t* bsrc[4]; const bf16_t* bsrc2[4];
#pragma unroll
    for (int i = 0; i < 2; ++i) { const int row = (2 * wid + i) * 16 + rl; asrc[i] = ap(row) + ((cp ^ swz4(row)) << 3); }
#pragma unroll
    for (int i = 0; i < 4; ++i) { const int row = (4 * wid + i) * 16 + rl; bsrc[i] = bp(row) + ((cp ^ swz4(row)) << 3); bsrc2[i] = bp2(row) + ((cp ^ swz4(row)) << 3) - ksplit * 32; }
    unsigned char* const dstA = lds + (2 * wid) * 1024 + lane * 16;
    unsigned char* const dstB = lds + 8192 + (4 * wid) * 1024 + lane * 16;
    auto issue = [&](int kt, int st) {
#pragma unroll
        for (int i = 0; i < 4; ++i) GLDS16((kt < ksplit ? bsrc[i] : bsrc2[i]) + kt * 32, dstB + st * 24576 + i * 1024);
#pragma unroll
        for (int i = 0; i < 2; ++i) GLDS16(asrc[i] + kt * 32, dstA + st * 24576 + i * 1024);
    };
    f32x4 acc[4][8];
#pragma unroll
    for (int mi = 0; mi < 4; ++mi)
#pragma unroll
        for (int ni = 0; ni < 8; ++ni) acc[mi][ni] = (f32x4){0.f, 0.f, 0.f, 0.f};
    const int KT = K / 32;
    const int rdo = ((fq ^ swz4(fr)) << 4) + fr * 64;
    issue(0, 0); issue(1, 1);
    if (GS) (void)gsf(std::integral_constant<int, -1>(), 0);
    int st = 0;
#pragma unroll 1
    for (int kt = 0; kt < KT; ++kt) {
        if (kt + 1 < KT) WAIT_VM(6); else WAIT_VM(0);
        RAW_BARRIER();
        const unsigned char* As = lds + st * 24576 + (wr * 64) * 64 + rdo;
        const unsigned char* Bs = lds + st * 24576 + 8192 + (wc * 128) * 64 + rdo;
        bf16x8 af[4], bfr[8];
#pragma unroll
        for (int mi = 0; mi < 4; ++mi) af[mi] = *(const bf16x8*)(As + mi * 1024);
#pragma unroll
        for (int ni = 0; ni < 8; ++ni) bfr[ni] = *(const bf16x8*)(Bs + ni * 1024);
        SETPRIO(1);
#pragma unroll
        for (int ni = 0; ni < 8; ++ni)
#pragma unroll
            for (int mi = 0; mi < 4; ++mi) acc[mi][ni] = MFMA16(bfr[ni], af[mi], acc[mi][ni]);
        SETPRIO(0);
        if (GS) {
            auto scale = [&](auto gtag) {
#pragma unroll
                for (int mi = 0; mi < 4; ++mi) { const float sc = gsf(gtag, mi);
#pragma unroll
                    for (int ni = 0; ni < 8; ++ni) acc[mi][ni] *= sc; }
            };
            if (kt == 7) scale(std::integral_constant<int, 0>());
            else if (kt == 15) scale(std::integral_constant<int, 1>());
            else if (kt == KT - 1) scale(std::integral_constant<int, 2>());
        }
        if (kt + 2 < KT) issue(kt + 2, st >= 1 ? st - 1 : 2);
        st = st == 2 ? 0 : st + 1;
    }
    RAW_BARRIER();
    { const int tz = tidx(), lz = tz & 63, wz = tz >> 6;
      epi(acc, wz >> 1, wz & 1, lz & 15, lz >> 4); }
}

#ifdef EMU
static inline float xhalf_max2(float v, float) { const float pv = __shfl_xor(v, 32); return (emu_lane() & 32) ? pv : v; }
#else
__device__ __forceinline__ float xhalf_max2(float v, float other) {
    const auto r = __builtin_amdgcn_permlane32_swap(__builtin_bit_cast(unsigned, other), __builtin_bit_cast(unsigned, v), false, false);
    return (threadIdx.x & 32) ? __builtin_bit_cast(float, r[0]) : v; }
#endif
struct AttnArgs {
    const bf16_t* q;
    const bf16_t* kn;
    const bf16_t* kr;
    const bf16_t* vt;
    int n1;
    int jlo, jhi;
    int tq;
    float sink2;
    bf16_t* o;
    float* ss;
};
template <bool MLA>
__device__ __forceinline__ void attn_unit(const AttnArgs& a, unsigned char* lds) {
    constexpr int NKS = MLA ? 6 : 4;
    const int tid = tidx(), lane = tid & 63, r = lane & 31, h = lane >> 5;
    const int kap = (r & ~12) | ((r & 4) << 1) | ((r & 8) >> 1);
    bf16x8 qf[NKS];
#pragma unroll
    for (int ks = 0; ks < NKS; ++ks) qf[ks] = *(const bf16x8*)(a.q + ks * 16 + h * 8);
    f32x16 o0, o1;
#pragma unroll
    for (int e = 0; e < 16; ++e) { o0[e] = 0.f; o1[e] = 0.f; }
    float m = -1e30f, l = 0.f;
    const int ntl = a.n1 + (a.jhi > a.jlo ? (a.jhi - a.jlo) / 64 : 0);
    const int wv = tid >> 6;
    int okn[2], ovt[2];
#pragma unroll
    for (int q = 0; q < 2; ++q) { const int row = (2 * wv + q) * 8 + (lane >> 3), sw = ((lane & 7) ^ ((row >> 1) & 7)) * 8; okn[q] = row * 64 + sw; ovt[q] = row * J + sw; }
    const int krow = 16 * wv + (lane >> 2), okr = krow * 32 + (((lane & 3) ^ ((krow >> 2) & 3)) * 8);
    auto tile_j0 = [&](int i) { return i < a.n1 ? 64 * i : a.jlo + 64 * (i - a.n1); };
    auto issue = [&](int j, int st) {
        const int jk = tile_j0(j + 1 < ntl ? j + 1 : ntl - 1), jv = tile_j0(j > 0 ? j - 1 : 0);
        unsigned char* b = lds + st * 20480 + lane * 16;
#pragma unroll
        for (int q = 0; q < 2; ++q) GLDS16(a.kn + (size_t)jk * 64 + okn[q], b + (2 * wv + q) * 1024);
#pragma unroll
        for (int q = 0; q < 2; ++q) GLDS16(a.vt + jv + ovt[q], b + 8192 + (2 * wv + q) * 1024);
        if (MLA) GLDS16(a.kr + (size_t)jk * 32 + okr, b + 16384 + wv * 1024);
    };
    auto qk = [&](int st, f32x16& s0, f32x16& s1) {
        const unsigned char* b = lds + st * 20480;
#pragma unroll
        for (int e = 0; e < 16; ++e) { s0[e] = 0.f; s1[e] = 0.f; }
#pragma unroll
        for (int ks = 0; ks < NKS; ++ks) {
            bf16x8 k0, k1;
            if (ks < 4) {
                const int row0 = kap, row1 = 32 + kap, c = 2 * ks + h;
                k0 = *(const bf16x8*)(b + row0 * 128 + ((c ^ ((row0 >> 1) & 7)) << 4));
                k1 = *(const bf16x8*)(b + row1 * 128 + ((c ^ ((row1 >> 1) & 7)) << 4));
            } else {
                const int row0 = kap, row1 = 32 + kap, c = 2 * (ks - 4) + h;
                k0 = *(const bf16x8*)(b + 16384 + row0 * 64 + ((c ^ ((row0 >> 2) & 3)) << 4));
                k1 = *(const bf16x8*)(b + 16384 + row1 * 64 + ((c ^ ((row1 >> 2) & 3)) << 4));
            }
            s0 = MFMA32(k0, qf[ks], s0);
            s1 = MFMA32(k1, qf[ks], s1);
        }
    };
    auto pv = [&](int st, const u32x4 (&pw)[4]) {
        const unsigned char* b = lds + st * 20480;
#pragma unroll
        for (int s4 = 0; s4 < 4; ++s4) {
            const bf16x8 pf = __builtin_bit_cast(bf16x8, pw[s4]);
            const int c = 2 * s4 + h;
            const bf16x8 v0 = *(const bf16x8*)(b + 8192 + r * 128 + ((c ^ ((r >> 1) & 7)) << 4));
            const bf16x8 v1 = *(const bf16x8*)(b + 8192 + (32 + r) * 128 + ((c ^ (((32 + r) >> 1) & 7)) << 4));
            o0 = MFMA32(v0, pf, o0);
            o1 = MFMA32(v1, pf, o1);
        }
    };
    issue(-1, 0); issue(0, 1);
    if (MLA) WAIT_VM(5); else WAIT_VM(4);
    RAW_BARRIER();
    f32x16 c0, c1;
    qk(0, c0, c1);
    issue(1, 2);
    if (MLA) WAIT_VM(5); else WAIT_VM(4);
    RAW_BARRIER();
    u32x4 pw[4];
#pragma unroll
    for (int s4 = 0; s4 < 4; ++s4) pw[s4] = (u32x4){0u, 0u, 0u, 0u};
    int st = 1;
#pragma unroll 1
    for (int i = 0; i < ntl; ++i) {
        if (i + 2 <= ntl) issue(i + 2, st == 0 ? 2 : st - 1);
        if (!MLA) {
            if (i >= a.n1) {
                const int tk0 = tile_j0(i) - LC + 8 * h;
#pragma unroll
                for (int e = 0; e < 16; ++e) {
                    const int tk = tk0 + 16 * (e >> 3) + (e & 7);
                    int d0 = a.tq - tk; d0 = d0 < 0 ? -d0 : d0; int d1 = a.tq - (tk + 32); d1 = d1 < 0 ? -d1 : d1;
                    if (d0 > 128) c0[e] = -1e30f;
                    if (d1 > 128) c1[e] = -1e30f;
                }
            }
        }
        constexpr int NT = 2 * NKS + 8, NMAX = MLA ? 4 : 2, NE = NT - NMAX;
        const unsigned char* sb_ = lds + st * 20480;
        auto frag = [&](int t) -> bf16x8 {
            if (t < 2 * NKS) { const int ks = t >> 1, row = (t & 1) * 32 + kap;
                if (ks < 4) { const int c = 2 * ks + h; return *(const bf16x8*)(sb_ + row * 128 + ((c ^ ((row >> 1) & 7)) << 4)); }
                else { const int c = 2 * (ks - 4) + h; return *(const bf16x8*)(sb_ + 16384 + row * 64 + ((c ^ ((row >> 2) & 3)) << 4)); } }
            else { const int u = t - 2 * NKS, s4 = u >> 1, row = (u & 1) * 32 + r, c = 2 * s4 + h; return *(const bf16x8*)(sb_ + 8192 + row * 128 + ((c ^ ((row >> 1) & 7)) << 4)); }
        };
        f32x16 n0, n1;
#pragma unroll
        for (int e = 0; e < 16; ++e) { n0[e] = 0.f; n1[e] = 0.f; }
        bf16x8 F[NT];
        F[0] = frag(0); F[1] = frag(1); F[2] = frag(2);
        float mx = c0[0], ps = 0.f, mn = 0.f, alpha = 0.f;
        SETPRIO(1);
        SCHED_FENCE();
#pragma unroll
        for (int t = 0; t < NT; ++t) {
            if (t < 2 * NKS) { const int ks = t >> 1; if (t & 1) n1 = MFMA32(F[t], qf[ks], n1); else n0 = MFMA32(F[t], qf[ks], n0); }
            else { const int u = t - 2 * NKS; const bf16x8 pf = __builtin_bit_cast(bf16x8, pw[u >> 1]); if (u & 1) o1 = MFMA32(F[t], pf, o1); else o0 = MFMA32(F[t], pf, o0); }
            if (t + 3 < NT) F[t + 3] = frag(t + 3);
            if (t < NMAX) {
                constexpr int PER = 32 / NMAX;
#pragma unroll
                for (int k = 0; k < PER; ++k) { const int e = t * PER + k; mx = fmaxf(mx, e < 16 ? c0[e] : c1[e - 16]); }
                if (t == NMAX - 1) { mx = xhalf_max2(mx, m); mn = fmaxf(m, mx); alpha = fast_exp2(m - mn); m = mn; }
                PIN1(mx);
            } else {
                const int s_ = t - NMAX;
                float mnk = mn; PIN1(mnk);
#pragma unroll
                for (int e = s_ * 16 / NE; e < (s_ + 1) * 16 / NE; ++e) { float x0 = fast_exp2(c0[e] - mnk), x1 = fast_exp2(c1[e] - mnk); PIN2(x0, x1); c0[e] = x0; c1[e] = x1; ps += x0 + x1; }
            }
            SCHED_FENCE();
        }
        SETPRIO(0);
        l = l * alpha + ps;
#pragma unroll
        for (int s4 = 0; s4 < 4; ++s4) {
            const int e0 = 8 * (s4 & 1);
            if (s4 < 2) pw[s4] = (u32x4){pack2(c0[e0], c0[e0 + 1]), pack2(c0[e0 + 2], c0[e0 + 3]), pack2(c0[e0 + 4], c0[e0 + 5]), pack2(c0[e0 + 6], c0[e0 + 7])};
            else pw[s4] = (u32x4){pack2(c1[e0], c1[e0 + 1]), pack2(c1[e0 + 2], c1[e0 + 3]), pack2(c1[e0 + 4], c1[e0 + 5]), pack2(c1[e0 + 6], c1[e0 + 7])};
        }
#pragma unroll
        for (int e = 0; e < 16; ++e) { o0[e] *= alpha; o1[e] *= alpha; }
        c0 = n0; c1 = n1;
        if (i + 2 <= ntl) { if (MLA) WAIT_VM(5); else WAIT_VM(4); } else WAIT_VM(0);
        RAW_BARRIER();
        st = st == 2 ? 0 : st + 1;
    }
    pv(st, pw);
    RAW_BARRIER();
    float lt = l + __shfl_xor(l, 32);
    if (!MLA) lt += fast_exp2(a.sink2 - m);
    const float inv = 1.0f / lt;
    float ssq = 0.f;
#pragma unroll
    for (int e = 0; e < 16; ++e) { o0[e] *= inv; o1[e] *= inv; ssq += o0[e] * o0[e] + o1[e] * o1[e]; }
    ssq += __shfl_xor(ssq, 32);
#pragma unroll
    for (int gp = 0; gp < 2; ++gp) {
        const int g = 2 * gp;
        *(u32x4*)(a.o + 8 * (g + h)) = widen_pair32((u32x2){pack2(o0[4 * g], o0[4 * g + 1]), pack2(o0[4 * g + 2], o0[4 * g + 3])}, (u32x2){pack2(o0[4 * g + 4], o0[4 * g + 5]), pack2(o0[4 * g + 6], o0[4 * g + 7])});
        *(u32x4*)(a.o + 32 + 8 * (g + h)) = widen_pair32((u32x2){pack2(o1[4 * g], o1[4 * g + 1]), pack2(o1[4 * g + 2], o1[4 * g + 3])}, (u32x2){pack2(o1[4 * g + 4], o1[4 * g + 5]), pack2(o1[4 * g + 6], o1[4 * g + 7])});
    }
    if (h == 0) *a.ss = ssq;
}

__device__ __forceinline__ int unit_of(int round, int bid, int nb) {
    return (nb % 8 == 0) ? round * nb + (bid % 8) * (nb / 8) + bid / 8 : round * nb + bid;
}
#define FOR_UNITS(u, total) for (int _rd = 0, u = unit_of(0, bid, nb); (_rd * nb) < (total); ++_rd, u = unit_of(_rd, bid, nb)) if (u < (total))
#define FOR_UNITS_ROT(u, total, rot) for (int _rd = 0, _b2 = (bid + (rot)) % nb, u = unit_of(0, _b2, nb); (_rd * nb) < (total); ++_rd, u = unit_of(_rd, _b2, nb)) if (u < (total))

__device__ __forceinline__ void mod_unit(const Params& p, int u, unsigned char* lds) {
    constexpr int NCHK = 6 * D / 64;
    const int l = u / NCHK, ck = u % NCHK, tid = tidx(), lane = tid & 63, w = tid >> 6;
    float* sl = (float*)lds;
    for (int i = tid; i < 17 * D; i += NTHREADS) { const int r = i / D, k = i % D; const float v = r < NB ? p.in[1][r * D + k] : p.in[3][k]; sl[i] = v / (1.0f + expf(-v)); }
    __syncthreads();
    float acc[17];
#pragma unroll
    for (int r = 0; r < 17; ++r) acc[r] = 0.f;
    const float* W = p.in[4] + (size_t)l * D * 6 * D + ck * 64 + lane;
    for (int k0 = w * (D / 4); k0 < (w + 1) * (D / 4); k0 += 16) {
        float wv[16];
#pragma unroll
        for (int j = 0; j < 16; ++j) wv[j] = W[(size_t)(k0 + j) * 6 * D];
#pragma unroll
        for (int j = 0; j < 16; ++j)
#pragma unroll
            for (int r = 0; r < 17; ++r) acc[r] += sl[r * D + k0 + j] * wv[j]; }
    __syncthreads();
    float* red = (float*)lds;
#pragma unroll
    for (int r = 0; r < 17; ++r) red[(w * 17 + r) * 64 + lane] = acc[r];
    __syncthreads();
    for (int i = tid; i < 17 * 64; i += NTHREADS) { const int r = i / 64, c = i % 64;
        const float s = ((red[(0 * 17 + r) * 64 + c] + red[(1 * 17 + r) * 64 + c]) + red[(2 * 17 + r) * 64 + c]) + red[(3 * 17 + r) * 64 + c];
        ((float*)(p.ws + WS_MOD))[(size_t)(l * 17 + r) * 6 * D + ck * 64 + c] = s + p.in[5][(size_t)l * 6 * D + ck * 64 + c]; }
    __syncthreads();
}
__device__ __forceinline__ void tr_tile(const float* src, int sld, bf16_t* dst, int dld, int k0, int n0, int nmax, const float* gk, float scale, unsigned char* lds) {
    float* t = (float*)lds;
    const int tid = tidx();
#pragma unroll
    for (int i = 0; i < 16; ++i) { const int k = i * 4 + (tid >> 6), n = tid & 63;
        const bool ok = n0 + n < nmax; const int nc = ok ? n0 + n : nmax - 1;
        const float v = src[(size_t)(k0 + k) * sld + nc] * (gk ? gk[k0 + k] : 1.0f) * scale;
        t[k * 65 + n] = ok ? v : 0.f; }
    __syncthreads();
#pragma unroll 4
    for (int i = 0; i < 8; ++i) { const int n = i * 8 + (tid >> 5), k = 2 * (tid & 31);
        if (n0 + n < nmax) *(unsigned*)(dst + (size_t)(n0 + n) * dld + k0 + k) = pack2(t[k * 65 + n], t[(k + 1) * 65 + n]); }
    __syncthreads();
}
constexpr int TR_IN = (D / 64) * 31, TR_UQ = 24, TR_UKV = 16, TR_OUT = 16 * (D / 64), TR_LRU = 128, TR_RT = 5 * (D / 64), TR_EX = 32 * 3 * 4 * (D / 64);
constexpr int TR_PER_LAYER = TR_IN + TR_UQ + TR_UKV + TR_OUT + TR_LRU + TR_RT + TR_EX;
__device__ __forceinline__ void tr_unit(const Params& p, int u, unsigned char* lds) {
    const int l = u / TR_PER_LAYER; int t = u % TR_PER_LAYER;
    constexpr int KD = D / 64;
    if (t < TR_IN) { const int kt = t / 31, nt = t % 31; tr_tile(p.in[8] + (size_t)l * D * INC, INC, (bf16_t*)(p.ws + WS_WIN) + (size_t)l * 2048 * D, D, kt * 64, nt * 64, INC, nullptr, 1.f, lds); return; }
    t -= TR_IN;
    if (t < TR_UQ) { const int kt = t / 6, nt = t % 6; tr_tile(p.in[10] + (size_t)l * 256 * 384, 384, (bf16_t*)(p.ws + WS_WUQ) + (size_t)l * 384 * 256, 256, kt * 64, nt * 64, 384, p.in[9] + l * 256, 0.10206207261596577f * LOG2E, lds); return; }
    t -= TR_UQ;
    if (t < TR_UKV) { const int kt = t / 8, nt = t % 8; tr_tile(p.in[12] + (size_t)l * 128 * 512, 512, (bf16_t*)(p.ws + WS_WUKV) + (size_t)l * 512 * 128, 128, kt * 64, nt * 64, 512, p.in[11] + l * 128, 1.f, lds); return; }
    t -= TR_UKV;
    if (t < TR_OUT) { const int kt = t / KD, nt = t % KD; tr_tile(p.in[22] + (size_t)l * MIXW * D, D, (bf16_t*)(p.ws + WS_WOUT) + (size_t)l * D * MIXW, MIXW, kt * 64, nt * 64, D, p.in[21] + l * MIXW, 1.f, lds); return; }
    t -= TR_OUT;
    if (t < TR_LRU) { const int tap = t >> 5, dir = (t >> 4) & 1, gate = (t >> 3) & 1, n = t & 7;
        tr_tile((gate ? p.in[18] : p.in[16]) + ((size_t)(l * 2 + dir) * 8 + n) * 4096, 64, (bf16_t*)(p.ws + WS_WLRU) + (((((size_t)(l * 8 + n) * 2 + dir) * 4 + tap) * 2 + gate) * 64) * 64, 64, 0, 0, 64,
                p.in[14] + (size_t)l * 4 * 512 + tap * 512 + n * 64, -LOG2E, lds); return; }
    t -= TR_LRU;
    if (t < TR_RT) { const int which = t / KD, kt = t % KD; bf16_t* dst = (bf16_t*)(p.ws + WS_WRT) + (size_t)l * 64 * D;
        if (which == 0) tr_tile(p.in[23] + (size_t)l * D * 4, 4, dst, D, kt * 64, 0, 4, nullptr, 1.f, lds);
        else { const int g = which - 1; tr_tile(p.in[25] + ((size_t)l * 4 + g) * D * 8, 8, dst + (size_t)(4 + 8 * g) * D, D, kt * 64, 0, 8, nullptr, 1.f, lds); }
        return; }
    t -= TR_RT;
    { const int e = t / (12 * KD); int r = t % (12 * KD); const int which = r / (4 * KD); r %= 4 * KD;
        if (which < 2) { const int kt = r / 4, nt = r % 4;
            tr_tile(p.in[27 + which] + ((size_t)l * 32 + e) * D * DE, DE, (bf16_t*)(p.ws + (which ? WS_WEU : WS_WEG)) + ((size_t)l * 32 + e) * DE * D, D, kt * 64, nt * 64, DE, nullptr, 1.f, lds); }
        else { const int kt = r / KD, nt = r % KD;
            tr_tile(p.in[29] + ((size_t)l * 32 + e) * DE * D, D, (bf16_t*)(p.ws + WS_WED) + ((size_t)l * 32 + e) * D * DE, DE, kt * 64, nt * 64, D, nullptr, 1.f, lds); } }
}
__device__ __forceinline__ void rope_unit(const Params& p) {
    const int f = tidx(); if (f >= 24) return;
    const double fr16[16] = {1.0, 0.5623413251903491, 0.31622776601683794, 0.1778279410038923, 0.1, 0.05623413251903491, 0.031622776601683791, 0.01778279410038923,
                             0.01, 0.005623413251903491, 0.0031622776601683794, 0.001778279410038923, 0.001, 0.0005623413251903491, 0.00031622776601683794, 0.0001778279410038923};
    const double w = f < 16 ? fr16[f] : fr16[2 * (f - 16)];
    double c1 = 1.0, s1 = 0.0, term = 1.0;
    for (int n = 1; n <= 24; ++n) { term *= w / n; if (n & 1) s1 += ((n >> 1) & 1) ? -term : term; else c1 += ((n >> 1) & 1) ? -term : term; }
    float* T = (float*)(p.ws + WS_ROPE);
    double c = 1.0, s = 0.0;
    for (int pos = 0; pos < 64; ++pos) {
        if (f < 16) { T[pos * 16 + f] = (float)c; T[1024 + pos * 16 + f] = (float)s; }
        else { T[2048 + pos * 8 + (f - 16)] = (float)c; T[2560 + pos * 8 + (f - 16)] = (float)s; }
        const double cn = c * c1 - s * s1, sn = s * c1 + c * s1; c = cn; s = sn;
    }
}
constexpr int N_MOD_UNITS = DEPTH * 6 * D / 64, N_TR_UNITS = DEPTH * TR_PER_LAYER;
__device__ __forceinline__ void phase_prologue(const Params& p, int bid, int nb, unsigned char* lds) {
    for (int u = bid; u < N_MOD_UNITS; u += nb) mod_unit(p, u, lds);
    for (int u = nb - 1 - bid; u < N_TR_UNITS; u += nb) tr_unit(p, u, lds);
    if (bid == nb / 2) rope_unit(p);
}

template <int MODE, class XF, class YF, class MF>
__device__ __forceinline__ void norm_run(const Params& p, int layer, const float* g, int which_sc, int which_sh, int r0, int r1, int lane, const XF& xf, const YF& yf, const MF& mf) {
    constexpr int NV = D / 256;
    f32x4 gm[NV], sh[NV]; int cur = -2;
    for (int rb = r0; rb < r1; rb += 4) {
        f32x4 v[4][NV];
#pragma unroll
        for (int q = 0; q < 4; ++q) { const int row = rb + q < r1 ? rb + q : r1 - 1;
#pragma unroll
            for (int i = 0; i < NV; ++i) v[q][i] = xf(row, (i * 64 + lane) * 4); }
        float ss[4];
#pragma unroll
        for (int q = 0; q < 4; ++q) { float a = 0.f;
#pragma unroll
            for (int i = 0; i < NV; ++i) a += v[q][i][0] * v[q][i][0] + v[q][i][1] * v[q][i][1] + v[q][i][2] * v[q][i][2] + v[q][i][3] * v[q][i][3];
            ss[q] = a; }
#pragma unroll
        for (int o = 32; o >= 1; o >>= 1) {
#pragma unroll
            for (int q = 0; q < 4; ++q) ss[q] += __shfl_xor(ss[q], o); }
#pragma unroll
        for (int q = 0; q < 4; ++q) { const int row = rb + q; if (row < r1) {
            const int mi = mf(row);
            if (mi != cur) { cur = mi;
#pragma unroll
                for (int i = 0; i < NV; ++i) { const int k = (i * 64 + lane) * 4; const f32x4 gv = *(const f32x4*)(g + k);
                    if (MODE == 0) { const f32x4 scv = *(const f32x4*)(mod_ptr(p, layer, mi, which_sc) + k); gm[i] = gv * (scv + 1.0f); sh[i] = *(const f32x4*)(mod_ptr(p, layer, mi, which_sh) + k); }
                    else { gm[i] = gv; sh[i] = (f32x4){0.f, 0.f, 0.f, 0.f}; } } }
            const float r = fast_rsqrt(ss[q] * (1.0f / D) + EPS);
#pragma unroll
            for (int i = 0; i < NV; ++i) { const int k = (i * 64 + lane) * 4; const f32x4 o = v[q][i] * r * gm[i] + sh[i];
                if (MODE == 0) *(u32x2*)((bf16_t*)yf(row) + k) = (u32x2){pack2(o[0], o[1]), pack2(o[2], o[3])};
                else *(f32x4*)((float*)yf(row) + k) = o; } } }
    }
}
__device__ __forceinline__ void phase_norm1(const Params& p, int layer, int bid, int nb) {
    const int lane = tidx() & 63, gw = bid * 4 + (tidx() >> 6), nw = nb * 4;
    bf16_t* H = (bf16_t*)(p.ws + WS_H);
    const int per = (R + nw - 1) / nw, r0 = gw * per, r1 = r0 + per < R ? r0 + per : R;
    norm_run<0>(p, layer, p.in[6] + layer * D, 1, 0, r0, r1, lane, [&](int row, int k) { return xload4(p, layer, row, k); }, [&](int row) { return (void*)(H + (size_t)row * D); }, [&](int row) { return mod_index(row); });
}
__device__ __forceinline__ void phase_final(const Params& p, int bid, int nb) {
    const int lane = tidx() & 63, gw = bid * 4 + (tidx() >> 6), nw = nb * 4;
    const int per = (NB * S + nw - 1) / nw, r0 = gw * per, r1 = r0 + per < NB * S ? r0 + per : NB * S;
    norm_run<1>(p, 0, p.in[30], 0, 0, r0, r1, lane, [&](int i, int k) { return xload4s(p, (i / S) * J + LC + (i % S), k); }, [&](int i) { return (void*)(p.out + (size_t)i * D); }, [&](int) { return 0; });
}

__device__ __forceinline__ void phase_inproj(const Params& p, int layer, int bid, int nb, unsigned char* lds) {
    const bf16_t* H = (const bf16_t*)(p.ws + WS_H); const bf16_t* W = (const bf16_t*)(p.ws + WS_WIN) + (size_t)layer * 2048 * D;
    bf16_t* Z = (bf16_t*)(p.ws + WS_Z); float* ZSS = (float*)(p.ws + WS_ZSS);
    constexpr int NT = 8, total = (R / 128) * NT;
    FOR_UNITS(u, total) {
        const int mt = u / NT, nt = u % NT;
        const bf16_t* zrow = (const bf16_t*)(p.ws + WS_ZROW);
        auto ap = [&](int r) -> const bf16_t* { return H + (size_t)(mt * 128 + r) * D; };
        auto bp = [&](int n) -> const bf16_t* { const int c = nt * 256 + n; return c < INC ? W + (size_t)c * D : zrow; };
        auto epi = [&](const f32x4 (&acc)[4][8], int wr, int wc, int fr, int fq) {
#pragma unroll
            for (int mi = 0; mi < 4; ++mi) { const int row = mt * 128 + wr * 64 + mi * 16 + fr; float ss = 0.f;
#pragma unroll
                for (int np = 0; np < 4; ++np) { const f32x4 va = acc[mi][2 * np], vb = acc[mi][2 * np + 1];
                    ss += (va[0] * va[0] + va[1] * va[1] + va[2] * va[2] + va[3] * va[3]) + (vb[0] * vb[0] + vb[1] * vb[1] + vb[2] * vb[2] + vb[3] * vb[3]);
                    const u32x4 o = widen_pair((u32x2){pack2(va[0], va[1]), pack2(va[2], va[3])}, (u32x2){pack2(vb[0], vb[1]), pack2(vb[2], vb[3])});
                    const int col = nt * 256 + wc * 128 + (2 * np + (fq & 1)) * 16 + (fq & 2) * 4;
                    if (col < INC) *(u32x4*)(Z + (size_t)row * INC + col) = o; }
                if (nt == 0 || (nt == 1 && wc == 0)) { ss += __shfl_xor(ss, 16); ss += __shfl_xor(ss, 32); if (fq == 0) ZSS[(size_t)row * 8 + nt * 2 + wc] = ss; } }
        };
        gemm_tile2<false>(ap, bp, bp, D, D / 32, lds, NoGS(), epi);
    }
}

__device__ __forceinline__ void prep_q_unit(const Params& p, int layer, int u, unsigned char* lds) {
    const int mt = u / 3, nt = u % 3;
    const bf16_t* Z = (const bf16_t*)(p.ws + WS_Z); const float* ZSS = (const float*)(p.ws + WS_ZSS);
    const bf16_t* W = (const bf16_t*)(p.ws + WS_WUQ) + (size_t)layer * 384 * 256; bf16_t* Q = (bf16_t*)(p.ws + WS_Q);
    const float* T8 = (const float*)(p.ws + WS_ROPE) + 2048;
    auto ap = [&](int r) -> const bf16_t* { return Z + (size_t)(mt * 128 + r) * INC + C_CQ; };
    auto bp = [&](int n) -> const bf16_t* { return W + (size_t)(nt * 128 + n) * 256; };
    auto epi = [&](const f32x4 (&acc)[4][4], int wr, int wc, int fr, int fq) {
#pragma unroll
        for (int mi = 0; mi < 4; ++mi) { const int row = mt * 128 + wr * 64 + mi * 16 + fr, b = row / J, j = row - b * J;
            const float* zs = ZSS + (size_t)row * 8; const float rs = fast_rsqrt((zs[0] + zs[1]) * (1.0f / 256.0f) + EPS);
            const bool lat = j >= LC; const int t = j - LC, prow = t / GW, pcol = t % GW;
            u32x2 pk[4];
#pragma unroll
            for (int ni = 0; ni < 4; ++ni) { const int c16 = nt * 8 + wc * 4 + ni, g16 = c16 % 6; f32x4 v = acc[mi][ni] * rs;
                if (g16 >= 4) {
                    f32x4 o;
#pragma unroll
                    for (int e = 0; e < 4; ++e) o[e] = __shfl_xor(v[e], 32);
                    if (lat) { const int pos = g16 == 4 ? prow : pcol; const float* cs = T8 + pos * 8 + (fq & 1) * 4; const float* sn = cs + 512;
#pragma unroll
                        for (int e = 0; e < 4; ++e) v[e] = fq < 2 ? v[e] * cs[e] - o[e] * sn[e] : v[e] * cs[e] + o[e] * sn[e]; } }
                pk[ni] = (u32x2){pack2(v[0], v[1]), pack2(v[2], v[3])}; }
#pragma unroll
            for (int np = 0; np < 2; ++np) { const u32x4 ow = widen_pair(pk[2 * np], pk[2 * np + 1]);
                const int c16 = nt * 8 + wc * 4 + 2 * np + (fq & 1), g16 = c16 % 6, head = c16 / 6;
                *(u32x4*)(Q + ((size_t)(b * 4 + head) * J + j) * 96 + g16 * 16 + (fq & 2) * 4) = ow; } }
    };
    gemm_tile<4, false>(ap, bp, bp, 256, 4, lds, NoGS(), epi);
}
__device__ __forceinline__ void prep_kv_unit(const Params& p, int layer, int u, unsigned char* lds) {
    const int mt = u / 4, hd = u % 4;
    const bf16_t* Z = (const bf16_t*)(p.ws + WS_Z); const float* ZSS = (const float*)(p.ws + WS_ZSS);
    const bf16_t* W = (const bf16_t*)(p.ws + WS_WUKV) + (size_t)layer * 512 * 128; bf16_t* KN = (bf16_t*)(p.ws + WS_KN); bf16_t* VT = (bf16_t*)(p.ws + WS_VT);
    auto ap = [&](int r) -> const bf16_t* { return Z + (size_t)(mt * 128 + r) * INC + C_CKV; };
    auto bp = [&](int n) -> const bf16_t* { return W + (size_t)(hd * 128 + n) * 128; };
    auto epi = [&](const f32x4 (&acc)[4][4], int wr, int wc, int fr, int fq) {
#pragma unroll
        for (int mi = 0; mi < 4; ++mi) { const int row = mt * 128 + wr * 64 + mi * 16 + fr, b = row / J, j = row - b * J;
            const float* zs = ZSS + (size_t)row * 8; const float rs = fast_rsqrt(zs[2] * (1.0f / 128.0f) + EPS);
            if (wc == 0) {
#pragma unroll
                for (int np = 0; np < 2; ++np) { const f32x4 va = acc[mi][2 * np] * rs, vb = acc[mi][2 * np + 1] * rs;
                    const u32x4 ow = widen_pair((u32x2){pack2(va[0], va[1]), pack2(va[2], va[3])}, (u32x2){pack2(vb[0], vb[1]), pack2(vb[2], vb[3])});
                    *(u32x4*)(KN + ((size_t)(b * 4 + hd) * J + j) * 64 + (2 * np + (fq & 1)) * 16 + (fq & 2) * 4) = ow; }
            } else {
#pragma unroll
                for (int ni = 0; ni < 4; ++ni) { const f32x4 v = acc[mi][ni] * rs; const int c = ni * 16 + fq * 4;
#pragma unroll
                    for (int e = 0; e < 4; ++e) *(bf16_t*)(lds + (c + e) * 272 + (wr * 64 + mi * 16 + fr) * 2) = f2bf(v[e]); } } }
        __syncthreads();
        { const int t_ = tidx(), l_ = t_ & 63, w_ = t_ >> 6, b = (mt * 128) / J, j0 = mt * 128 - b * J;
#pragma unroll
          for (int i = 0; i < 4; ++i) { const int d = w_ * 16 + i * 4 + (l_ >> 4), ch = l_ & 15;
              *(u32x4*)(VT + ((size_t)(b * 4 + hd) * 64 + d) * J + j0 + ch * 8) = *(const u32x4*)(lds + d * 272 + ch * 16); } }
        __syncthreads();
    };
    gemm_tile<4, false>(ap, bp, bp, 128, 2, lds, NoGS(), epi);
}
__device__ __forceinline__ void rope8(u32x4& A, u32x4& B, const float* cs, const float* sn, bool rot, float scale) {
#pragma unroll
    for (int i = 0; i < 4; ++i) {
        const float a0 = bf2f((bf16_t)(A[i] & 0xffff)), a1 = bf2f((bf16_t)(A[i] >> 16)), b0 = bf2f((bf16_t)(B[i] & 0xffff)), b1 = bf2f((bf16_t)(B[i] >> 16));
        float c0 = 1.f, s0 = 0.f, c1 = 1.f, s1 = 0.f; if (rot) { c0 = cs[2 * i]; s0 = sn[2 * i]; c1 = cs[2 * i + 1]; s1 = sn[2 * i + 1]; }
        A[i] = pack2((a0 * c0 - b0 * s0) * scale, (a1 * c1 - b1 * s1) * scale);
        B[i] = pack2((b0 * c0 + a0 * s0) * scale, (b1 * c1 + a1 * s1) * scale); }
}
__device__ __forceinline__ void prep_rope_unit(const Params& p, int u, unsigned char* lds) {
    const bf16_t* Z = (const bf16_t*)(p.ws + WS_Z);
    bf16_t* KR = (bf16_t*)(p.ws + WS_KR); bf16_t* SQ = (bf16_t*)(p.ws + WS_SQ); bf16_t* SK = (bf16_t*)(p.ws + WS_SK); bf16_t* SVT = (bf16_t*)(p.ws + WS_SVT);
    const float* T16 = (const float*)(p.ws + WS_ROPE); const float* T8 = T16 + 2048;
    const int tid = tidx(), row0 = u * 64;
    for (int job = tid; job < 64 * 26; job += NTHREADS) {
        const int rl = job / 26, q = job % 26, row = row0 + rl, b = row / J, j = row - b * J; const bool lat = j >= LC; const int t = j - LC, prow = t / GW, pcol = t % GW;
        const bf16_t* z = Z + (size_t)row * INC;
        if (q < 2) {
            u32x4 A = *(const u32x4*)(z + C_KR + q * 16), B = *(const u32x4*)(z + C_KR + q * 16 + 8);
            const int pos = q == 0 ? prow : pcol; rope8(A, B, T8 + pos * 8, T8 + 512 + pos * 8, lat, 1.0f);
            bf16_t* d = KR + ((size_t)b * J + j) * 32 + q * 16; *(u32x4*)d = A; *(u32x4*)(d + 8) = B;
        } else {
            const int qq = q - 2, isk = qq >= 16, hq = isk ? (qq - 16) >> 2 : qq >> 2, part = qq & 3, axis = part >> 1, half8 = part & 1;
            const int cbase = (isk ? C_SK : C_SQ) + hq * 64 + axis * 32 + half8 * 8;
            u32x4 A = *(const u32x4*)(z + cbase), B = *(const u32x4*)(z + cbase + 16);
            const int pos = axis == 0 ? prow : pcol; rope8(A, B, T16 + pos * 16 + half8 * 8, T16 + 1024 + pos * 16 + half8 * 8, lat, isk ? 1.0f : 0.125f * LOG2E);
            bf16_t* d = (isk ? SK + ((size_t)(b * 2 + hq) * J + j) * 64 : SQ + ((size_t)(b * 4 + hq) * J + j) * 64) + axis * 32 + half8 * 8;
            *(u32x4*)d = A; *(u32x4*)(d + 16) = B;
        }
    }
    bf16_t* t = (bf16_t*)lds;
    for (int c = tid; c < 64 * 16; c += NTHREADS) { const int rl = c >> 4, ch = c & 15; *(u32x4*)(t + rl * 136 + ch * 8) = *(const u32x4*)(Z + (size_t)(row0 + rl) * INC + C_SV + ch * 8); }
    __syncthreads();
    { const int b = row0 / J, j0 = row0 - b * J, w_ = tid >> 6, dl = (tid >> 3) & 7, ch = tid & 7;
#pragma unroll
        for (int i = 0; i < 4; ++i) { const int d = w_ * 32 + i * 8 + dl; u32x4 o;
#pragma unroll
            for (int e = 0; e < 4; ++e) o[e] = (unsigned)t[(ch * 8 + 2 * e) * 136 + d] | ((unsigned)t[(ch * 8 + 2 * e + 1) * 136 + d] << 16);
            *(u32x4*)(SVT + ((size_t)(b * 2 + (d >> 6)) * 64 + (d & 63)) * J + j0 + ch * 8) = o; } }
    __syncthreads();
}

struct AB { float a, b; };
__device__ __forceinline__ AB comb(AB L, AB Rr) { return AB{Rr.a * L.a, Rr.a * L.b + Rr.b}; }
#ifdef EMU
#define WAVE_SYNC() emu_wave_sync()
#define BLOCK_FENCE() do {} while (0)
#define SPIN_WAIT(cond) while (!(cond)) emu_yield()
#define LDSAS
#define LDS_ORDER() emu_wave_sync()
#else
#define SPIN_WAIT(cond) while (!(cond)) __builtin_amdgcn_s_sleep(1)
#define LDSAS __attribute__((address_space(3)))
#define LDS_ORDER() asm volatile("s_waitcnt lgkmcnt(0)" ::: "memory")
#define WAVE_SYNC() asm volatile("" ::: "memory")
#define BLOCK_FENCE() __builtin_amdgcn_fence(__ATOMIC_SEQ_CST, "workgroup")
#endif
constexpr int N_LRUS = NB * 32, LRU_IT = J / 256, LRU_ITC = LC / 256;
template <int DIR>
__device__ __forceinline__ void lru_seq_pass(const Params& p, int layer, bool last, int u, unsigned char* lds) {
    const int n = u & 7, q = (u >> 3) & 3, b = u >> 5;
    const int tid = tidx(), lane = tid & 63, w = tid >> 6, fr = lane & 15, fq = lane >> 4;
    const bf16_t* Z = (const bf16_t*)(p.ws + WS_Z);
    unsigned char* st = lds + w * 9216;
    unsigned char* wl = lds + 36864;
    volatile LDSAS int* flg = (volatile LDSAS int*)(lds + 57344);
    volatile LDSAS float* cout_ = (volatile LDSAS float*)(lds + 57344 + 64);
    const int cg = n * 64 + 16 * q + fr;
    bf16x8 wfr[4];
    { const bf16_t* WL = (const bf16_t*)(p.ws + WS_WLRU) + ((((size_t)(layer * 8 + n) * 2 + DIR) * 4 + w) * 2) * 4096;
#pragma unroll
      for (int idx = 0; idx < 4; ++idx) { const int ri = idx >> 1, ks = idx & 1; wfr[idx] = *(const bf16x8*)(WL + (size_t)ri * 4096 + (16 * q + fr) * 64 + ks * 32 + fq * 8); } }
    const float cwv = p.in[14][(size_t)layer * 4 * 512 + w * 512 + cg];
    float br, bi;
    {
        const float* wa = p.in[16] + ((size_t)(layer * 2 + DIR) * 8 + n) * 4096 + 16 * q + fr; const float* wx = p.in[18] + ((size_t)(layer * 2 + DIR) * 8 + n) * 4096 + 16 * q + fr;
        const float* cb = p.in[15] + layer * 512 + n * 64;
        float sr = 0.f, si = 0.f;
        float cv[16], av_[16], xv_[16];
#pragma unroll
        for (int k = 0; k < 16; ++k) { cv[k] = cb[fq * 16 + k]; av_[k] = wa[(fq * 16 + k) * 64]; xv_[k] = wx[(fq * 16 + k) * 64]; }
#pragma unroll
        for (int k = 0; k < 16; ++k) { sr += cv[k] * av_[k]; si += cv[k] * xv_[k]; }
        sr += __shfl_xor(sr, 16); sr += __shfl_xor(sr, 32); si += __shfl_xor(si, 16); si += __shfl_xor(si, 32);
        br = -LOG2E * (sr + p.in[17][(layer * 2 + DIR) * 512 + cg]); bi = -LOG2E * (si + p.in[19][(layer * 2 + DIR) * 512 + cg]);
    }
    const float cbo = p.in[15][layer * 512 + cg], lam = p.in[20][(layer * 2 + DIR) * 512 + cg];
    const float xe = expf(-lam); const float sp = xe * (1.0f - xe * (0.5f - xe * (1.0f / 3.0f - xe * 0.25f)));
    const float spl = -8.0f * LOG2E * sp;
    bf16_t* HFu = (bf16_t*)(p.ws + WS_HF) + (size_t)u * 16 * J + (size_t)fr * J;
    bf16_t* M = (bf16_t*)(p.ws + WS_H); float* SSo = (float*)(p.ws + WS_SS);
    const int rr = lane >> 3, ch8 = lane & 7, qh = q >> 1;
    const bf16_t* zrow_ = (const bf16_t*)(p.ws + WS_ZROW);
    auto jp_of = [&](int it) -> int { return DIR == 0 ? it * 256 : (it < LRU_ITC ? LC - 256 * (it + 1) : J - 256 * (it - LRU_ITC + 1)); };
    u32x4 zr[9];
    auto load_rows = [&](int it) {
        const int jp0 = jp_of(it), j0 = jp0 + 64 * w, seg_lo = jp0 < LC ? 0 : LC, seg_hi = jp0 < LC ? LC : J;
#pragma unroll
        for (int i = 0; i < 9; ++i) { const int s = rr + 8 * i, j = j0 - 2 + s; const bool ok = j >= seg_lo && j < seg_hi && s < 67;
            const bf16_t* src = ok ? Z + (size_t)(b * J + j) * INC + C_LX + n * 64 + ch8 * 8 : zrow_;
            zr[i] = *(const u32x4*)src; }
    };
    load_rows(0);
    {
#pragma unroll
        for (int idx = 0; idx < 4; ++idx) *(bf16x8*)(wl + (w * 5 + idx) * 1024 + lane * 16) = wfr[idx];
        const short cwb = (short)f2bf(cwv);
        const bool mine = fq == 2 * (q & 1) + (fr >> 3);
        bf16x8 dg;
#pragma unroll
        for (int e = 0; e < 8; ++e) dg[e] = (mine && e == (fr & 7)) ? cwb : (short)0;
        *(bf16x8*)(wl + (w * 5 + 4) * 1024 + lane * 16) = dg;
    }
    if (tid < 4) flg[tid] = 0;
    const int pw = DIR == 0 ? (w + 3) & 3 : (w + 1) & 3;
    const bool firstw = DIR == 0 ? w == 0 : w == 3;
    __syncthreads();
#pragma unroll 1
    for (int it = 0; it < LRU_IT; ++it) {
        const int jp0 = jp_of(it), j0 = jp0 + 64 * w; const bool outp = DIR == 1 && !(last && jp0 < LC);
        WAVE_SYNC();
#pragma unroll
        for (int i = 0; i < 9; ++i) *(u32x4*)(st + (rr + 8 * i) * 128 + ((ch8 ^ rr) << 4)) = zr[i];
        WAVE_SYNC();
        if (it + 1 < LRU_IT) load_rows(it + 1);
        f32x4 hfv[4]; u32x4 z7a, z7b;
        if (DIR == 1) {
#pragma unroll
            for (int mp = 0; mp < 2; ++mp) {
                const u32x4 hw = *(const u32x4*)(HFu + j0 + (2 * mp + (fq & 1)) * 16 + (fq & 2) * 4);
                unsigned h0 = hw[0], h1 = hw[1], h2 = hw[2], h3 = hw[3]; swap16(h0, h2); swap16(h1, h3);
                hfv[2 * mp] = (f32x4){__builtin_bit_cast(float, h0 << 16), __builtin_bit_cast(float, h0 & 0xffff0000u), __builtin_bit_cast(float, h1 << 16), __builtin_bit_cast(float, h1 & 0xffff0000u)};
                hfv[2 * mp + 1] = (f32x4){__builtin_bit_cast(float, h2 << 16), __builtin_bit_cast(float, h2 & 0xffff0000u), __builtin_bit_cast(float, h3 << 16), __builtin_bit_cast(float, h3 & 0xffff0000u)}; }
            const bf16_t* zp = Z + ((size_t)b * J + j0 + lane) * INC + C_LG + n * 64 + 16 * q;
            z7a = *(const u32x4*)zp; z7b = *(const u32x4*)(zp + 8);
        }
        f32x4 acc[4][3];
#pragma unroll
        for (int mi = 0; mi < 4; ++mi)
            { acc[mi][0] = (f32x4){br, br, br, br}; acc[mi][1] = (f32x4){bi, bi, bi, bi}; acc[mi][2] = (f32x4){cbo, cbo, cbo, cbo}; }
        SETPRIO(1);
#pragma unroll
        for (int tap = 0; tap < 4; ++tap) {
#pragma unroll
            for (int ks = 0; ks < 2; ++ks) {
                bf16x8 uf[4];
#pragma unroll
                for (int mi = 0; mi < 4; ++mi) { const int s = mi * 16 + fr + tap; uf[mi] = *(const bf16x8*)(st + s * 128 + (((ks * 4 + fq) ^ (s & 7)) << 4)); }
                const bf16x8 wr_ = *(const bf16x8*)(wl + (tap * 5 + ks) * 1024 + lane * 16), wi_ = *(const bf16x8*)(wl + (tap * 5 + 2 + ks) * 1024 + lane * 16);
#pragma unroll
                for (int mi = 0; mi < 4; ++mi) { acc[mi][0] = MFMA16(uf[mi], wr_, acc[mi][0]); acc[mi][1] = MFMA16(uf[mi], wi_, acc[mi][1]); }
                if (ks == qh) { const bf16x8 wd_ = *(const bf16x8*)(wl + (tap * 5 + 4) * 1024 + lane * 16);
#pragma unroll
                    for (int mi = 0; mi < 4; ++mi) acc[mi][2] = MFMA16(uf[mi], wd_, acc[mi][2]); }
            }
        }
        float av[4][4], bv[4][4];
#pragma unroll
        for (int mi = 0; mi < 4; ++mi)
#pragma unroll
            for (int e = 0; e < 4; ++e) {
                const float r = fast_rcp(1.0f + fast_exp2(acc[mi][0][e])), ig = fast_rcp(1.0f + fast_exp2(acc[mi][1][e]));
                const float a_ = fast_exp2(r * spl);
                av[mi][e] = a_;
                bv[mi][e] = fast_sqrt(fmaxf(1.0f - a_ * a_, 0.f)) * (ig * acc[mi][2][e]);
            }
        SETPRIO(0);
        const int ord = DIR == 0 ? fq : 3 - fq;
        AB pre[4], ttot[4], tot{1.f, 0.f};
#pragma unroll
        for (int q4 = 0; q4 < 4; ++q4) { const int mi = DIR == 0 ? q4 : 3 - q4; AB s{1.f, 0.f};
            if (DIR == 0) {
#pragma unroll
                for (int e = 0; e < 4; ++e) s = comb(s, AB{av[mi][e], bv[mi][e]}); }
            else {
#pragma unroll
                for (int e = 3; e >= 0; --e) s = comb(s, AB{av[mi][e], bv[mi][e]}); }
            { AB o{__shfl(s.a, DIR == 0 ? lane - 16 : lane + 16), __shfl(s.b, DIR == 0 ? lane - 16 : lane + 16)}; if (ord >= 1) s = comb(o, s); }
            { AB o{__shfl(s.a, DIR == 0 ? lane - 32 : lane + 32), __shfl(s.b, DIR == 0 ? lane - 32 : lane + 32)}; if (ord >= 2) s = comb(o, s); }
            pre[mi] = s;
            const AB tl{__shfl(s.a, DIR == 0 ? 48 + fr : fr), __shfl(s.b, DIR == 0 ? 48 + fr : fr)};
            ttot[mi] = tl; tot = comb(tot, tl); }
        SETPRIO(2);
        float hin = 0.f;
        { const int need = firstw ? it : it + 1;
          if (need > 0) { SPIN_WAIT(flg[pw] >= need); hin = cout_[pw * 16 + fr]; }
          const float hout = tot.a * hin + tot.b;
          if (fq == 0) cout_[w * 16 + fr] = hout;
          LDS_ORDER();
          if (lane == 0) flg[w] = it + 1; }
        SETPRIO(0);
        float hv[4][4];
#pragma unroll
        for (int q4 = 0; q4 < 4; ++q4) { const int mi = DIR == 0 ? q4 : 3 - q4;
            const float hafter = pre[mi].a * hin + pre[mi].b;
            float hh = __shfl(hafter, DIR == 0 ? lane - 16 : lane + 16); if (ord == 0) hh = hin;
            if (DIR == 0) {
#pragma unroll
                for (int e = 0; e < 4; ++e) { hh = av[mi][e] * hh + bv[mi][e]; hv[mi][e] = hh; } }
            else {
#pragma unroll
                for (int e = 3; e >= 0; --e) { hh = av[mi][e] * hh + bv[mi][e]; hv[mi][e] = hh; } }
            hin = ttot[mi].a * hin + ttot[mi].b; }
        if (DIR == 0) {
#pragma unroll
            for (int mp = 0; mp < 2; ++mp) *(u32x4*)(HFu + j0 + (2 * mp + (fq & 1)) * 16 + (fq & 2) * 4) =
                widen_pair((u32x2){pack2(hv[2 * mp][0], hv[2 * mp][1]), pack2(hv[2 * mp][2], hv[2 * mp][3])}, (u32x2){pack2(hv[2 * mp + 1][0], hv[2 * mp + 1][1]), pack2(hv[2 * mp + 1][2], hv[2 * mp + 1][3])});
        } else if (outp) {
            unsigned char* zt = lds + 58368 + w * 4096;
            *(u32x4*)(zt + lane * 32) = z7a; *(u32x4*)(zt + lane * 32 + 16) = z7b;
            WAVE_SYNC();
#pragma unroll
            for (int mi = 0; mi < 4; ++mi)
#pragma unroll
                for (int e = 0; e < 4; ++e) { const int tk = mi * 16 + fq * 4 + e;
                    const float o = (hfv[mi][e] + hv[mi][e]) * gelu_tanh(bf2f(*(const bf16_t*)(zt + tk * 32 + fr * 2)));
                    *(bf16_t*)(zt + 2048 + tk * 32 + fr * 2) = f2bf(o); }
            WAVE_SYNC();
            const u32x4 oa = *(const u32x4*)(zt + 2048 + lane * 32), ob = *(const u32x4*)(zt + 2048 + lane * 32 + 16);
            const size_t row = (size_t)b * J + j0 + lane;
            bf16_t* mp = M + row * MIXW + 512 + n * 64 + 16 * q;
            *(u32x4*)mp = oa; *(u32x4*)(mp + 8) = ob;
            float ssq = 0.f;
#pragma unroll
            for (int k = 0; k < 4; ++k) { const float a0 = __builtin_bit_cast(float, oa[k] << 16), a1 = __builtin_bit_cast(float, oa[k] & 0xffff0000u), b0 = __builtin_bit_cast(float, ob[k] << 16), b1 = __builtin_bit_cast(float, ob[k] & 0xffff0000u);
                ssq += (a0 * a0 + a1 * a1) + (b0 * b0 + b1 * b1); }
            SSo[row * SSW + 8 + n * 4 + q] = ssq;
        }
    }
}
__device__ __forceinline__ void lru_seq_unit(const Params& p, int layer, bool last, int u, unsigned char* lds) {
    lru_seq_pass<0>(p, layer, last, u, lds);
    BLOCK_FENCE();
    __syncthreads();
    lru_seq_pass<1>(p, layer, last, u, lds);
    __syncthreads();
}
constexpr int N_PQ = (R / 128) * 3, N_PKV = (R / 128) * 4, N_PR = R / 64;
__device__ __forceinline__ void phase_prep(const Params& p, int layer, bool last, int bid, int nb, unsigned char* lds) {
    { FOR_UNITS(u, N_PQ) prep_q_unit(p, layer, u, lds); }
    { FOR_UNITS_ROT(u, N_PKV, 2) prep_kv_unit(p, layer, u, lds); }
    { FOR_UNITS_ROT(u, N_PR, 4) prep_rope_unit(p, u, lds); }
    { FOR_UNITS(u, N_LRUS) lru_seq_unit(p, layer, last, u, lds); }
}

constexpr int N_MLA_LAT = NB * 4 * (S / 128), N_MLA_CTX = NB * 4 * (LC / 128), N_SWA_LAT = NB * 2 * (S / 64), N_SWA_CTX = NB * 2 * (LC / 64);
__device__ __forceinline__ void mla_unit(const Params& p, int u, bool ctx, unsigned char* lds) {
    const int nqb = ctx ? LC / 128 : S / 128, bh = u / nqb, qb = u % nqb, b = bh >> 2, hd = bh & 3;
    const int lane = tidx() & 63, w = tidx() >> 6, j = (ctx ? 0 : LC) + qb * 128 + 32 * w + (lane & 31);
    AttnArgs a;
    a.q = (const bf16_t*)(p.ws + WS_Q) + ((size_t)bh * J + j) * 96; a.kn = (const bf16_t*)(p.ws + WS_KN) + (size_t)bh * J * 64;
    a.kr = (const bf16_t*)(p.ws + WS_KR) + (size_t)b * J * 32; a.vt = (const bf16_t*)(p.ws + WS_VT) + (size_t)bh * 64 * J;
    a.n1 = 0; a.jlo = 0; a.jhi = ctx ? LC : J; a.tq = 0; a.sink2 = 0.f;
    const size_t row = (size_t)b * J + j;
    a.o = (bf16_t*)(p.ws + WS_H) + row * MIXW + hd * 64; a.ss = (float*)(p.ws + WS_SS) + row * SSW + hd;
    attn_unit<true>(a, lds);
}
__device__ __forceinline__ void swa_unit(const Params& p, int layer, int u, bool ctx, unsigned char* lds) {
    const int nqb = ctx ? LC / 64 : S / 64, bk = u / nqb, qb = u % nqb, b = bk >> 1, kvh = bk & 1;
    const int lane = tidx() & 63, w = tidx() >> 6, hd = kvh * 2 + (w & 1), t0 = qb * 64, ql = 32 * (w >> 1) + (lane & 31), j = (ctx ? 0 : LC) + t0 + ql;
    AttnArgs a;
    a.q = (const bf16_t*)(p.ws + WS_SQ) + ((size_t)(b * 4 + hd) * J + j) * 64; a.kn = (const bf16_t*)(p.ws + WS_SK) + (size_t)bk * J * 64; a.kr = nullptr;
    a.vt = (const bf16_t*)(p.ws + WS_SVT) + (size_t)bk * 64 * J; a.n1 = LC / 64;
    if (ctx) { a.jlo = 0; a.jhi = 0; } else { const int lo = t0 - 128 < 0 ? 0 : t0 - 128, hi = t0 + 192 > S ? S : t0 + 192; a.jlo = LC + lo; a.jhi = LC + hi; }
    a.tq = t0 + ql; a.sink2 = p.in[13][layer * 4 + hd] * LOG2E;
    const size_t row = (size_t)b * J + j;
    a.o = (bf16_t*)(p.ws + WS_H) + row * MIXW + 256 + hd * 64; a.ss = (float*)(p.ws + WS_SS) + row * SSW + 4 + hd;
    attn_unit<false>(a, lds);
}
__device__ __forceinline__ void phase_attn_a(const Params& p, int layer, bool last, int bid, int nb, unsigned char* lds) {
    const int total = N_MLA_LAT + (last ? 0 : N_MLA_CTX);
    FOR_UNITS(u, total) { const bool ctx = u >= N_MLA_LAT; mla_unit(p, ctx ? u - N_MLA_LAT : u, ctx, lds); }
}
__device__ __forceinline__ void phase_attn_b(const Params& p, int layer, bool last, int bid, int nb, unsigned char* lds) {
    const int total = N_SWA_LAT + (last ? 0 : N_SWA_CTX);
    { FOR_UNITS(u, total) { const bool ctx = u >= N_SWA_LAT; swa_unit(p, layer, ctx ? u - N_SWA_LAT : u, ctx, lds); } }
}

__device__ __forceinline__ bool skip_ctx_tile(int mt, bool last) { return last && (mt % (J / 128)) < (LC / 128); }
__device__ __forceinline__ int n_tiles(bool last) { return last ? NB * (S / 128) : R / 128; }
__device__ __forceinline__ int tile_of(int v, bool last) { return last ? (v / (S / 128)) * (J / 128) + LC / 128 + v % (S / 128) : v; }
__device__ __forceinline__ void phase_outproj(const Params& p, int layer, bool last, int bid, int nb, unsigned char* lds) {
    const bf16_t* M = (const bf16_t*)(p.ws + WS_H); const bf16_t* W = (const bf16_t*)(p.ws + WS_WOUT) + (size_t)layer * D * MIXW; const float* SSi = (const float*)(p.ws + WS_SS);
    constexpr int NT = D / 256; const int all = n_tiles(last) * NT, total = all >= nb ? (all / nb) * nb : all, remu = all - total;
    FOR_UNITS(v, remu * 4) {
        const int u = total + (v >> 2), part = v & 3, mt = tile_of(u / NT, last), nt = u % NT, cbase = nt * 256 + part * 64;
        const int tid_ = tidx(), wr_ = (tid_ >> 6) >> 1, fr_ = tid_ & 15;
        float* gs = (float*)(lds + 74240);
        if (tid_ < 128) { const f32x4* s4 = (const f32x4*)(SSi + (size_t)(mt * 128 + tid_) * SSW);
            const f32x4 sa = s4[0], sb = s4[1]; f32x4 sc = s4[2];
#pragma unroll
            for (int i = 3; i < SSW / 4; ++i) sc += s4[i];
            const float m0 = ((sa[0] + sa[1]) + (sa[2] + sa[3])) * (1.0f / 256.0f) + EPS, m1 = ((sb[0] + sb[1]) + (sb[2] + sb[3])) * (1.0f / 256.0f) + EPS;
            const float m2 = ((sc[0] + sc[1]) + (sc[2] + sc[3])) * (1.0f / 512.0f) + EPS;
            gs[tid_] = sqrtf(m1 / m0); gs[128 + tid_] = sqrtf(m2 / m1); gs[256 + tid_] = fast_rsqrt(m2); }
        __syncthreads();
        auto ap = [&](int r) -> const bf16_t* { return M + (size_t)(mt * 128 + r) * MIXW; };
        auto bp = [&](int n) -> const bf16_t* { return W + (size_t)(cbase + n) * MIXW; };
        auto gsf = [&](auto gtag, int mi) -> float { return gs[decltype(gtag)::value * 128 + wr_ * 64 + mi * 16 + fr_]; };
        auto epi = [&](const f32x4 (&acc)[4][2], int wr, int wc, int fr, int fq) {
#pragma unroll
            for (int mi = 0; mi < 4; ++mi) { const int row = mt * 128 + wr * 64 + mi * 16 + fr; const float* gt = mod_ptr(p, layer, mod_index(row), 2);
                { f32x4 lo = acc[mi][0], hi = acc[mi][1]; widen_acc(lo, hi);
                  resid8<true>(p, layer, row, cbase + wc * 32 + (fq & 1) * 16 + (fq & 2) * 4, gt, lo, hi); } }
        };
        gemm_tile<2, true>(ap, bp, bp, MIXW, MIXW / 64, lds, gsf, epi);
        __syncthreads();
    }
    FOR_UNITS(u, total) {
        const int mt = tile_of(u / NT, last), nt = u % NT;
        const int tid_ = tidx(), wr_ = (tid_ >> 6) >> 1, fr_ = tid_ & 15;
        float* gs = (float*)(lds + 74240);
        auto gsfill = [&]() {
            if (tid_ < 128) { const f32x4* s4 = (const f32x4*)(SSi + (size_t)(mt * 128 + tid_) * SSW);
                const f32x4 sa = s4[0], sb = s4[1]; f32x4 sc = s4[2];
#pragma unroll
                for (int i = 3; i < SSW / 4; ++i) sc += s4[i];
                const float m0 = ((sa[0] + sa[1]) + (sa[2] + sa[3])) * (1.0f / 256.0f) + EPS, m1 = ((sb[0] + sb[1]) + (sb[2] + sb[3])) * (1.0f / 256.0f) + EPS;
                const float m2 = ((sc[0] + sc[1]) + (sc[2] + sc[3])) * (1.0f / 512.0f) + EPS;
                gs[tid_] = sqrtf(m1 / m0); gs[128 + tid_] = sqrtf(m2 / m1); gs[256 + tid_] = fast_rsqrt(m2); }
            __syncthreads();
        };
        auto ap = [&](int r) -> const bf16_t* { return M + (size_t)(mt * 128 + r) * MIXW; };
        auto bp = [&](int n) -> const bf16_t* { return W + (size_t)(nt * 256 + n) * MIXW; };
        auto gsf = [&](auto gtag, int mi) -> float { if constexpr (decltype(gtag)::value < 0) { gsfill(); return 0.f; } else return gs[decltype(gtag)::value * 128 + wr_ * 64 + mi * 16 + fr_]; };
        auto epi = [&](const f32x4 (&acc)[4][8], int wr, int wc, int fr, int fq) {
#pragma unroll
            for (int mi = 0; mi < 4; ++mi) { const int row = mt * 128 + wr * 64 + mi * 16 + fr; const float* gt = mod_ptr(p, layer, mod_index(row), 2);
#pragma unroll
                for (int np = 0; np < 4; ++np) { f32x4 lo = acc[mi][2 * np], hi = acc[mi][2 * np + 1]; widen_acc(lo, hi);
                    resid8<true>(p, layer, row, nt * 256 + wc * 128 + (2 * np + (fq & 1)) * 16 + (fq & 2) * 4, gt, lo, hi); }
#ifndef EMU
                asm volatile("" ::: "memory");
#endif
            }
        };
        gemm_tile2<true>(ap, bp, bp, MIXW, MIXW / 32, lds, gsf, epi);
    }
}

__device__ __forceinline__ void phase_norm2_route(const Params& p, int layer, bool last, int bid, int nb, unsigned char* lds) {
    bf16_t* H = (bf16_t*)(p.ws + WS_H); const bf16_t* W = (const bf16_t*)(p.ws + WS_WRT) + (size_t)layer * 64 * D;
    unsigned* cnt = (unsigned*)(p.ws + WS_CNT) + layer * 128; int* list = (int*)(p.ws + WS_LIST); float* lw = (float*)(p.ws + WS_LW);
    const int tid = tidx(), lane = tid & 63, w = tid >> 6;
    const int ntile = n_tiles(last), FT = ntile >= nb ? (ntile / nb) * nb : ntile, rem = ntile - FT;
    int SUBS = 1; while (SUBS < 16 && rem * SUBS * 2 <= nb) SUBS *= 2;
    const int total = FT + rem * SUBS;
    FOR_UNITS(u, total) {
        int rowbase, nrows;
        if (u < FT) { rowbase = tile_of(u, last) * 128; nrows = 128; }
        else { const int v2 = u - FT; nrows = 128 / SUBS; rowbase = tile_of(FT + v2 / SUBS, last) * 128 + (v2 % SUBS) * nrows; }
        const int rpw = nrows / 4;
        norm_run<0>(p, layer, p.in[7] + layer * D, 4, 3, rowbase + w * rpw, rowbase + w * rpw + rpw, lane, [&](int row, int k) { return xload4s(p, row, k); }, [&](int row) { return (void*)(H + (size_t)row * D); }, [&](int row) { return mod_index(row); });
        __syncthreads();
        float* lg = (float*)lds;
        const bf16_t* zrow = (const bf16_t*)(p.ws + WS_ZROW);
        auto ap = [&](int r) -> const bf16_t* { return r < nrows ? H + (size_t)(rowbase + r) * D : zrow; };
        auto bp = [&](int n) -> const bf16_t* { return n < 36 ? W + (size_t)n * D : zrow; };
        auto epi = [&](const f32x4 (&acc)[4][2], int wr, int wc, int fr, int fq) {
#pragma unroll
            for (int mi = 0; mi < 4; ++mi)
#pragma unroll
                for (int ni = 0; ni < 2; ++ni) { const int col = wc * 32 + ni * 16 + fq * 4; if (col < 40) *(f32x4*)(lg + (wr * 64 + mi * 16 + fr) * 40 + col) = acc[mi][ni]; }
        };
        gemm_tile<2, false>(ap, bp, bp, D, D / 64, lds, NoGS(), epi);
        __syncthreads();
        if (tid < nrows) { const int row = rowbase + tid; const float* l = lg + tid * 40;
            const float* b1 = p.in[24] + layer * 4; const float* b2 = p.in[26] + layer * 32;
            float g0 = l[0] + b1[0]; int g = 0;
#pragma unroll
            for (int i = 1; i < 4; ++i) { const float v = l[i] + b1[i]; if (v > g0) { g0 = v; g = i; } }
            float den = 0.f;
#pragma unroll
            for (int i = 0; i < 4; ++i) den += expf(l[i] + b1[i] - g0);
            const float pg = 1.0f / den;
            float e1 = -3.0e38f, e2 = -3.0e38f; int i1 = 0, i2 = 0;
#pragma unroll
            for (int i = 0; i < 8; ++i) { const float v = l[4 + g * 8 + i] + b2[g * 8 + i];
                if (v > e1) { e2 = e1; i2 = i1; e1 = v; i1 = i; } else if (v > e2) { e2 = v; i2 = i; } }
            const float w1 = 1.0f / (1.0f + expf(e2 - e1)), w2 = 1.0f - w1;
            const int lo = i1 < i2 ? i1 : i2, hi = i1 < i2 ? i2 : i1; const float wlo = i1 < i2 ? w1 : w2, whi = i1 < i2 ? w2 : w1;
            const int pair = g * 28 + lo * (15 - lo) / 2 + (hi - lo - 1);
            const unsigned slot = atomicAdd(cnt + pair, 1u);
            list[(size_t)pair * R + slot] = row; lw[(size_t)row * 2] = pg * wlo; lw[(size_t)row * 2 + 1] = pg * whi; }
        __syncthreads();
    }
}

__device__ __forceinline__ int build_tiles(const Params& p, int layer, int* tstart) {
    const unsigned* cnt = (const unsigned*)(p.ws + WS_CNT) + layer * 128;
    const int tid = tidx();
    if (tid < 128) {
        const int lane = tid & 63; int v = tid < NPAIR ? ((int)cnt[tid] + 127) >> 7 : 0; const int own = v;
#pragma unroll
        for (int o = 1; o < 64; o <<= 1) { const int t = __shfl_up(v, o); if (lane >= o) v += t; }
        if (tid < 64) { tstart[tid] = v - own; if (lane == 63) tstart[NPAIR + 2] = v; }
        else tstart[NPAIR + 4 + lane] = v - own;
    }
    __syncthreads();
    if (tid >= 64 && tid < 128) { const int lane = tid & 63, base = tstart[NPAIR + 2]; if (tid < NPAIR) tstart[tid] = base + tstart[NPAIR + 4 + lane];
        if (tid == NPAIR) tstart[NPAIR] = base + tstart[NPAIR + 4 + lane]; }
    __syncthreads();
    return tstart[NPAIR];
}
__device__ __forceinline__ void pair_experts(int pair, int& elo, int& ehi) {
    const int g = pair / 28; int r = pair % 28, lo = 0; while (r >= 7 - lo) { r -= 7 - lo; ++lo; } elo = g * 8 + lo; ehi = g * 8 + lo + 1 + r;
}
__device__ __forceinline__ int find_pair(const int* tstart, int t) {
    int lo = 0, hi = NPAIR - 1;
    while (lo < hi) { const int mid = (lo + hi + 1) >> 1; if (tstart[mid] <= t) lo = mid; else hi = mid - 1; }
    return lo; }
__device__ __forceinline__ void phase_moe_up(const Params& p, int layer, int bid, int nb, unsigned char* lds) {
    int* tstart = (int*)(lds + 73728); const int T = build_tiles(p, layer, tstart);
    const bf16_t* H = (const bf16_t*)(p.ws + WS_H); bf16_t* ACT = (bf16_t*)(p.ws + WS_Z);
    const unsigned* cnt = (const unsigned*)(p.ws + WS_CNT) + layer * 128; const int* list = (const int*)(p.ws + WS_LIST); const float* lw = (const float*)(p.ws + WS_LW);
    const int total = T * 4;
    FOR_UNITS(u, total) {
        const int t = u >> 2, nt = u & 3, pair = find_pair(tstart, t), tl = t - tstart[pair], n = (int)cnt[pair]; int elo, ehi; pair_experts(pair, elo, ehi);
        const int half = nt >> 1, e = half ? ehi : elo, cb = (nt & 1) * 128;
        const bf16_t* Wg = (const bf16_t*)(p.ws + WS_WEG) + ((size_t)layer * 32 + e) * DE * D; const bf16_t* Wu = (const bf16_t*)(p.ws + WS_WEU) + ((size_t)layer * 32 + e) * DE * D;
        const int* lst = list + (size_t)pair * R + tl * 128;
        const bf16_t* zrow = (const bf16_t*)(p.ws + WS_ZROW);
        auto ap = [&](int r) -> const bf16_t* { return tl * 128 + r < n ? H + (size_t)lst[tl * 128 + r < n ? r : 0] * D : zrow; };
        auto bp = [&](int nn) -> const bf16_t* { const int wc = nn >> 7, t128 = nn & 127, col = cb + wc * 64 + (t128 & 63); return ((t128 >> 6) ? Wu : Wg) + (size_t)col * D; };
        float cwp[4];
        { const int t_ = tidx(), wr_ = (t_ >> 6) >> 1, fr_ = t_ & 15;
#pragma unroll
          for (int mi = 0; mi < 4; ++mi) { const int rl = wr_ * 64 + mi * 16 + fr_; const bool okr = tl * 128 + rl < n; cwp[mi] = okr ? lw[(size_t)lst[okr ? rl : 0] * 2 + half] : 0.f; } }
        auto epi = [&](const f32x4 (&acc)[4][8], int wr, int wc, int fr, int fq) {
#pragma unroll
            for (int mi = 0; mi < 4; ++mi) { const int rl = wr * 64 + mi * 16 + fr; const bool okr = tl * 128 + rl < n;
                const float cw = cwp[mi];
#pragma unroll
                for (int np = 0; np < 2; ++np) { u32x2 pk[2];
#pragma unroll
                    for (int h2 = 0; h2 < 2; ++h2) { const f32x4 g = acc[mi][2 * np + h2], uu = acc[mi][2 * np + h2 + 4]; float o[4];
#pragma unroll
                        for (int e4 = 0; e4 < 4; ++e4) o[e4] = siluf_(g[e4]) * uu[e4] * cw;
                        pk[h2] = (u32x2){pack2(o[0], o[1]), pack2(o[2], o[3])}; }
                    const u32x4 ow = widen_pair(pk[0], pk[1]);
                    if (okr) *(u32x4*)(ACT + (size_t)(t * 128 + rl) * 512 + half * 256 + cb + wc * 64 + (2 * np + (fq & 1)) * 16 + (fq & 2) * 4) = ow; } }
        };
        gemm_tile2<false>(ap, bp, bp, D, D / 32, lds, NoGS(), epi);
    }
}
__device__ __forceinline__ void phase_moe_down(const Params& p, int layer, int bid, int nb, unsigned char* lds) {
    int* tstart = (int*)(lds + 73728); const int T = build_tiles(p, layer, tstart);
    const bf16_t* ACT = (const bf16_t*)(p.ws + WS_Z);
    const unsigned* cnt = (const unsigned*)(p.ws + WS_CNT) + layer * 128; const int* list = (const int*)(p.ws + WS_LIST);
    constexpr int NT = D / 256; const int total = T * NT;
    FOR_UNITS(u, total) {
        const int t = u / NT, nt = u % NT, pair = find_pair(tstart, t), tl = t - tstart[pair], n = (int)cnt[pair]; int elo, ehi; pair_experts(pair, elo, ehi);
        const bf16_t* W0 = (const bf16_t*)(p.ws + WS_WED) + ((size_t)layer * 32 + elo) * D * DE; const bf16_t* W1 = (const bf16_t*)(p.ws + WS_WED) + ((size_t)layer * 32 + ehi) * D * DE;
        const int* lst = list + (size_t)pair * R + tl * 128;
        const bf16_t* zrow = (const bf16_t*)(p.ws + WS_ZROW);
        auto ap = [&](int r) -> const bf16_t* { return tl * 128 + r < n ? ACT + (size_t)(t * 128 + r) * 512 : zrow; };
        auto bp = [&](int nn) -> const bf16_t* { return W0 + (size_t)(nt * 256 + nn) * DE; };
        auto bp2 = [&](int nn) -> const bf16_t* { return W1 + (size_t)(nt * 256 + nn) * DE; };
        int rowp[4];
        { const int t_ = tidx(), wr_ = (t_ >> 6) >> 1, fr_ = t_ & 15;
#pragma unroll
          for (int mi = 0; mi < 4; ++mi) { const int rl = wr_ * 64 + mi * 16 + fr_; rowp[mi] = lst[tl * 128 + rl < n ? rl : 0]; } }
        auto epi = [&](const f32x4 (&acc)[4][8], int wr, int wc, int fr, int fq) {
#pragma unroll
            for (int mi = 0; mi < 4; ++mi) { const int rl = wr * 64 + mi * 16 + fr; const bool okr = tl * 128 + rl < n;
                const int row = rowp[mi]; const float* gt = mod_ptr(p, layer, mod_index(row), 5);
#pragma unroll
                for (int np = 0; np < 4; ++np) { f32x4 lo = acc[mi][2 * np], hi = acc[mi][2 * np + 1]; widen_acc(lo, hi);
                    if (okr) resid8<false>(p, layer, row, nt * 256 + wc * 128 + (2 * np + (fq & 1)) * 16 + (fq & 2) * 4, gt, lo, hi); }
#ifndef EMU
                asm volatile("" ::: "memory");
#endif
            }
        };
        gemm_tile2<false>(ap, bp, bp2, 512, 8, lds, NoGS(), epi);
    }
}

constexpr int LDS_BYTES = 75792;
#ifndef EMU
#define XB_TMO      128
#define XB_XCNT(j)  (256  + 64 * (j))
#define XB_XSUB(j)  (1280 + 64 * (j))
#define XB_XGEN(j)  (2304 + 64 * (j))
#define XB_TOP      3328
#define XB_TOPGEN   3392
#define XCD_BAR_WORDS 3456
#define XB_SPIN_CAP (1u << 18)
#define LAS __attribute__((address_space(3)))
static_assert(XCD_BAR_WORDS == XCD_BAR_WORDS_C, "barrier words");

__device__ __forceinline__ unsigned xb_ld(unsigned* p)              { return __hip_atomic_load(p, __ATOMIC_RELAXED, __HIP_MEMORY_SCOPE_AGENT); }
__device__ __forceinline__ unsigned xb_add(unsigned* p, unsigned v) { return __hip_atomic_fetch_add(p, v, __ATOMIC_RELAXED, __HIP_MEMORY_SCOPE_AGENT); }
__device__ __forceinline__ unsigned xb_xcc_id() { return (unsigned)__builtin_amdgcn_s_getreg((3 << 11) | 20) & 0xFu; }
#define XB_SPIN(cond, bar) do { unsigned _sp = 0; while (cond) { __builtin_amdgcn_s_sleep(1); \
    if ((++_sp & 255u) == 0u) { if (xb_ld(&(bar)[XB_TMO])) break; if (_sp > XB_SPIN_CAP) { atomicAdd(&(bar)[XB_TMO], 1u); break; } } } } while (0)

struct XcdBarrier { unsigned* bar; unsigned x; volatile LAS unsigned* st; };

__device__ __forceinline__ XcdBarrier xcd_barrier_post(unsigned* bar, volatile LAS unsigned* st) {
    XcdBarrier b; b.bar = bar; b.x = xb_xcc_id(); b.st = st;
    if (threadIdx.x == 0) (void)xb_add(&bar[XB_XCNT(b.x)], 1u);
    return b;
}
__device__ __forceinline__ void xcd_barrier_complete(unsigned* bar, unsigned x, unsigned& nloc, unsigned& nx) {
    const unsigned G = gridDim.x * gridDim.y * gridDim.z;
    unsigned sum, cnt, mine, sp = 0u;
    for (;;) {
        sum = 0u; cnt = 0u; mine = 0u;
#pragma unroll
        for (unsigned j = 0; j < 16; ++j) { const unsigned c = xb_ld(&bar[XB_XCNT(j)]); sum += c; cnt += (c > 0u) ? 1u : 0u; mine = (j == x) ? c : mine; }
        if (sum == G) break;
        __builtin_amdgcn_s_sleep(1);
        if ((++sp & 255u) == 0u) { if (xb_ld(&bar[XB_TMO])) break; if (sp > XB_SPIN_CAP) { atomicAdd(&bar[XB_TMO], 1u); break; } }
    }
    nloc = mine > 0u ? mine : 1u; nx = cnt > 0u ? cnt : 1u;
}
__device__ __forceinline__ void xcd_barrier(const XcdBarrier& b) {
    asm volatile("s_waitcnt vmcnt(0)" ::: "memory");
    __syncthreads();
    if (threadIdx.x == 0) {
        unsigned* bar = b.bar;
        __builtin_amdgcn_s_waitcnt(0);
        unsigned nloc = b.st[0], nx = b.st[1];
        if (nloc == 0u) { xcd_barrier_complete(bar, b.x, nloc, nx); b.st[0] = nloc; b.st[1] = nx; }
        const unsigned old = xb_add(&bar[XB_XSUB(b.x)], 1u);
        const unsigned gen = old / nloc;
        if (old + 1u == (gen + 1u) * nloc) {
            __builtin_amdgcn_fence(__ATOMIC_RELEASE, "agent");
            asm volatile("s_waitcnt vmcnt(0)" ::: "memory");
            const unsigned og = xb_add(&bar[XB_TOP], 1u);
            const unsigned tg = og / nx;
            if (og + 1u == (tg + 1u) * nx) xb_add(&bar[XB_TOPGEN], 1u);
            else XB_SPIN(xb_ld(&bar[XB_TOPGEN]) == tg, bar);
            __builtin_amdgcn_fence(__ATOMIC_ACQUIRE, "agent");
            xb_add(&bar[XB_XGEN(b.x)], 1u);
            asm volatile("s_waitcnt vmcnt(0)" ::: "memory");
        } else {
            XB_SPIN(xb_ld(&bar[XB_XGEN(b.x)]) == gen, bar);
            __builtin_amdgcn_fence(__ATOMIC_ACQUIRE, "agent");
            asm volatile("s_waitcnt vmcnt(0)" ::: "memory");
        }
    }
    __syncthreads();
}

__global__ void __launch_bounds__(NTHREADS, 2) fwd_kernel(Params p) {
    unsigned char* lds = SMEM_PTR();
    volatile LAS unsigned* st = (volatile LAS unsigned*)(lds + LDS_BYTES - 16);
    if (threadIdx.x == 0) { st[0] = 0u; st[1] = 0u; st[2] = 0u; st[3] = 0u; }
    __syncthreads();
    XcdBarrier bar = xcd_barrier_post((unsigned*)(p.ws + WS_BAR), st);
    const int bid = blockIdx.x, nb = gridDim.x;
    phase_prologue(p, bid, nb, lds);
    xcd_barrier(bar);
    for (int layer = 0; layer < DEPTH; ++layer) {
        const bool last = layer == DEPTH - 1;
        phase_norm1(p, layer, bid, nb);                  xcd_barrier(bar);
#if PROBE == 7
        phase_norm1(p, layer, bid, nb);                  xcd_barrier(bar);
#endif
        phase_inproj(p, layer, bid, nb, lds);            xcd_barrier(bar);
#if PROBE == 3
        phase_inproj(p, layer, bid, nb, lds);            xcd_barrier(bar);
#endif
        phase_prep(p, layer, last, bid, nb, lds);        xcd_barrier(bar);
#if PROBE == 6
        { FOR_UNITS(u, N_PQ) prep_q_unit(p, layer, u, lds); }
        { FOR_UNITS_ROT(u, N_PKV, 2) prep_kv_unit(p, layer, u, lds); }
        { FOR_UNITS_ROT(u, N_PR, 4) prep_rope_unit(p, u, lds); }
        xcd_barrier(bar);
#endif
        phase_attn_a(p, layer, last, bid, nb, lds);
        phase_attn_b(p, layer, last, bid, nb, lds);      xcd_barrier(bar);
#if PROBE == 4
        phase_attn_a(p, layer, last, bid, nb, lds);      xcd_barrier(bar);
#endif
#if PROBE == 8
        phase_attn_b(p, layer, last, bid, nb, lds);      xcd_barrier(bar);
#endif
        phase_outproj(p, layer, last, bid, nb, lds);     xcd_barrier(bar);
        phase_norm2_route(p, layer, last, bid, nb, lds); xcd_barrier(bar);
        phase_moe_up(p, layer, bid, nb, lds);            xcd_barrier(bar);
#if PROBE == 5
        phase_moe_up(p, layer, bid, nb, lds);            xcd_barrier(bar);
#endif
        phase_moe_down(p, layer, bid, nb, lds);          xcd_barrier(bar);
    }
    phase_final(p, bid, nb);
}

extern "C" void kernel_launch(void* const* d_in, const int* in_sizes, int n_in, void* d_out, int out_size, void* d_ws, size_t ws_size, hipStream_t stream) {
    static int grid = 0;
    if (grid == 0) {
        if (n_in != 31 || out_size != NB * S * D || ws_size < WS_END) { fprintf(stderr, "kernel_launch: unexpected shapes (n_in %d out %d ws %zu need %zu)\n", n_in, out_size, ws_size, (size_t)WS_END); grid = -1; return; }
        int dev = 0, cus = 0, per_cu = 0;
        if (hipGetDevice(&dev) != hipSuccess || hipDeviceGetAttribute(&cus, hipDeviceAttributeMultiprocessorCount, dev) != hipSuccess) { grid = -1; return; }
        if (hipFuncSetAttribute((const void*)fwd_kernel, hipFuncAttributeMaxDynamicSharedMemorySize, LDS_BYTES) != hipSuccess) { fprintf(stderr, "kernel_launch: hipFuncSetAttribute failed\n"); grid = -1; return; }
        if (hipOccupancyMaxActiveBlocksPerMultiprocessor(&per_cu, (const void*)fwd_kernel, NTHREADS, LDS_BYTES) != hipSuccess || per_cu < 1) { fprintf(stderr, "kernel_launch: occupancy query failed (%d)\n", per_cu); per_cu = 1; }
        (void)hipGetLastError();
        grid = cus * (per_cu < 2 ? per_cu : 2);
    }
    if (grid < 0) return;
    (void)in_sizes;
    if (hipMemsetAsync(d_ws, 0, WS_ZERO_BYTES, stream) != hipSuccess) return;
    Params p{};
    for (int i = 0; i < 31; ++i) p.in[i] = (const float*)d_in[i];
    p.out = (float*)d_out; p.ws = (unsigned char*)d_ws;
    hipLaunchKernelGGL(fwd_kernel, dim3(grid), dim3(NTHREADS), LDS_BYTES, stream, p);
}
#endif
```
